# Optimizing an MI355X kernel written in HIP

```python
import jax, jax.numpy as jnp
from jax import lax
import numpy as np

D_MODEL = 2048
BATCH = 2
SEQ = 4096
DEPTH = 2

PLE_DIM = 256
MIX_WIDTH = D_MODEL
NSA_HEADS = 16
NSA_KV_HEADS = 4
NSA_WIDTH = MIX_WIDTH // 2
NSA_HEAD_DIM = NSA_WIDTH // NSA_HEADS
NSA_KV_WIDTH = NSA_KV_HEADS * NSA_HEAD_DIM
CMP_LEN = 32
CMP_STRIDE = 16
SLC_BLOCK = 64
N_SELECT = 16
WINDOW = 512
Q_BLOCK = 128
LRU_WIDTH = MIX_WIDTH // 4
LRU_BLOCKS = 8
LRU_BLOCK_DIM = LRU_WIDTH // LRU_BLOCKS
CONV_WIDTH = 4
LRU_C = 8.0
GLA_WIDTH = MIX_WIDTH // 4
GLA_HEADS = 4
GLA_HEAD_DIM = GLA_WIDTH // GLA_HEADS
GLA_GATE_RANK = 16
GLA_GATE_TAU = 16.0
GLA_CHUNK = 64
D_FF = 4 * D_MODEL
EPS = 1e-6
NEG_INF = -1e30

IN_SIZES = (NSA_WIDTH, 6 * NSA_KV_WIDTH, 3 * NSA_HEADS,
            LRU_WIDTH, LRU_WIDTH,
            GLA_WIDTH, GLA_WIDTH, GLA_WIDTH, GLA_WIDTH, GLA_GATE_RANK)
D_IN = NSA_WIDTH + 6 * NSA_KV_WIDTH + 3 * NSA_HEADS + 2 * LRU_WIDTH + 4 * GLA_WIDTH + GLA_GATE_RANK

kernel_name = 'hybrid_nsa_rglru_gla_trunk'


def rms_norm(x, g):
    x32 = x.astype(jnp.float32)
    y = x32 * lax.rsqrt(jnp.mean(x32 * x32, axis=-1, keepdims=True) + EPS)
    return (y * g.astype(jnp.float32)).astype(x.dtype)


def alibi_slopes(n):
    return jnp.exp2(-8.0 * jnp.arange(1, n + 1, dtype=jnp.float32) / n)


def nsa_mixer(q, kv, gates, cmp_w, cmp_pe):
    B, T, _ = q.shape
    G, HPG, dk = NSA_KV_HEADS, NSA_HEADS // NSA_KV_HEADS, NSA_HEAD_DIM
    q = q.reshape(B, T, G, HPG, dk) * dk ** -0.5
    kc, vc, ks, vs, kw, vw = [a.reshape(B, T, G, dk) for a in jnp.split(kv, 6, axis=-1)]
    slopes = alibi_slopes(NSA_HEADS).reshape(G, HPG)
    pos = jnp.arange(T)

    n_cmp = (T - CMP_LEN) // CMP_STRIDE + 1
    cmp_start = jnp.arange(n_cmp) * CMP_STRIDE
    cmp_idx = cmp_start[:, None] + jnp.arange(CMP_LEN)[None, :]

    def compress(a, w, pe):
        blk = a[:, cmp_idx] + pe[None, None, :, None, :]
        blk = blk.transpose(0, 1, 3, 2, 4).reshape(B, n_cmp, G, CMP_LEN * dk)
        return blk @ w

    k_cmp = compress(kc, cmp_w[0], cmp_pe[0])
    v_cmp = compress(vc, cmp_w[1], cmp_pe[1])
    d_cmp = (pos[:, None] - (cmp_start + CMP_LEN - 1)[None, :]).astype(jnp.float32)
    valid_cmp = d_cmp >= 0
    s = jnp.einsum('btghd,bngd->bghtn', q, k_cmp).astype(jnp.float32) - slopes[:, :, None, None] * d_cmp
    s = jnp.where(valid_cmp, s, NEG_INF)
    p_cmp = jax.nn.softmax(s, axis=-1) * valid_cmp
    o_cmp = jnp.einsum('bghtn,bngd->btghd', p_cmp, v_cmp)

    n_slc = T // SLC_BLOCK
    n_sel = min(N_SELECT, n_slc)
    slc_start = jnp.arange(n_slc) * SLC_BLOCK
    overlap = ((cmp_start[:, None] < slc_start[None, :] + SLC_BLOCK)
               & (slc_start[None, :] < cmp_start[:, None] + CMP_LEN)).astype(jnp.float32)
    imp = jnp.einsum('bghtn,nj->bgtj', p_cmp, overlap)
    blk = jnp.arange(n_slc)[None, :]
    t_blk = (pos // SLC_BLOCK)[:, None]
    forced = (blk == 0) | (blk == t_blk) | (blk == t_blk - 1)
    score = jnp.where(blk > t_blk, -1.0, jnp.where(forced, 1e4, imp))
    _, sel_idx = lax.top_k(score, n_sel)

    ks_blk = ks.reshape(B, n_slc, SLC_BLOCK, G, dk).transpose(0, 3, 1, 2, 4)
    vs_blk = vs.reshape(B, n_slc, SLC_BLOCK, G, dk).transpose(0, 3, 1, 2, 4)
    kw_pad = jnp.pad(kw, ((0, 0), (WINDOW, 0), (0, 0), (0, 0)))
    vw_pad = jnp.pad(vw, ((0, 0), (WINDOW, 0), (0, 0), (0, 0)))

    n_qb = T // Q_BLOCK
    q_blocks = q.reshape(B, n_qb, Q_BLOCK, G, HPG, dk).transpose(1, 0, 2, 3, 4, 5)
    idx_blocks = sel_idx.reshape(B, G, n_qb, Q_BLOCK, n_sel).transpose(2, 0, 1, 3, 4)
    t_blocks = pos.reshape(n_qb, Q_BLOCK)
    b_ix = jnp.arange(B)[:, None, None, None]
    g_ix = jnp.arange(G)[None, :, None, None]
    blk_off = jnp.arange(SLC_BLOCK)
    win_off = jnp.arange(WINDOW + Q_BLOCK)

    def block_fn(args):
        q_b, idx_b, t_b = args
        k_sel = ks_blk[b_ix, g_ix, idx_b].reshape(B, G, Q_BLOCK, n_sel * SLC_BLOCK, dk)
        v_sel = vs_blk[b_ix, g_ix, idx_b].reshape(B, G, Q_BLOCK, n_sel * SLC_BLOCK, dk)
        k_pos = (idx_b[..., None] * SLC_BLOCK + blk_off).reshape(B, G, Q_BLOCK, n_sel * SLC_BLOCK)
        d_sel = (t_b[None, None, :, None] - k_pos).astype(jnp.float32)[:, :, None]
        s1 = jnp.einsum('bqghd,bgqkd->bghqk', q_b, k_sel).astype(jnp.float32) - slopes[None, :, :, None, None] * d_sel
        s1 = jnp.where(d_sel >= 0, s1, NEG_INF)
        o_sel = jnp.einsum('bghqk,bgqkd->bqghd', jax.nn.softmax(s1, axis=-1), v_sel)
        w_idx = t_b[0] + win_off
        k_win = kw_pad[:, w_idx]
        v_win = vw_pad[:, w_idx]
        d_win = (t_b[:, None] - (w_idx - WINDOW)[None, :]).astype(jnp.float32)
        valid = (d_win >= 0) & (d_win < WINDOW) & (w_idx >= WINDOW)[None, :]
        s2 = jnp.einsum('bqghd,bkgd->bghqk', q_b, k_win).astype(jnp.float32) - slopes[:, :, None, None] * d_win
        s2 = jnp.where(valid, s2, NEG_INF)
        o_win = jnp.einsum('bghqk,bkgd->bqghd', jax.nn.softmax(s2, axis=-1), v_win)
        return o_sel, o_win

    o_sel, o_win = lax.map(block_fn, (q_blocks, idx_blocks, t_blocks))
    o_sel = o_sel.transpose(1, 0, 2, 3, 4, 5).reshape(B, T, G, HPG, dk)
    o_win = o_win.transpose(1, 0, 2, 3, 4, 5).reshape(B, T, G, HPG, dk)
    g = jax.nn.sigmoid(gates.astype(jnp.float32)).reshape(B, T, G, HPG, 3)
    o = g[..., 0:1] * o_cmp + g[..., 1:2] * o_sel + g[..., 2:3] * o_win
    return o.reshape(B, T, NSA_WIDTH)


def _lin_combine(e1, e2):
    a1, b1 = e1
    a2, b2 = e2
    return a1 * a2, a2 * b1 + b2


def rglru_mixer(xb, yb, conv_w, conv_b, wa, ba, wi, bi, lam):
    B, T, _ = xb.shape
    xp = jnp.pad(xb, ((0, 0), (CONV_WIDTH - 1, 0), (0, 0)))
    xc = conv_b + sum(xp[:, k:k + T] * conv_w[k] for k in range(CONV_WIDTH))
    xr = xc.reshape(B, T, LRU_BLOCKS, LRU_BLOCK_DIM)
    r = jax.nn.sigmoid(jnp.einsum('btnc,ncd->btnd', xr, wa).reshape(B, T, LRU_WIDTH) + ba)
    i = jax.nn.sigmoid(jnp.einsum('btnc,ncd->btnd', xr, wi).reshape(B, T, LRU_WIDTH) + bi)
    log_a = -LRU_C * r.astype(jnp.float32) * jax.nn.softplus(-lam.astype(jnp.float32))
    a = jnp.exp(log_a)
    u = jnp.sqrt(-jnp.expm1(2.0 * log_a)) * (i * xc).astype(jnp.float32)
    _, h = lax.associative_scan(_lin_combine, (a, u), axis=1)
    return h * jax.nn.gelu(yb.astype(jnp.float32))


def gla_mixer(q, k, v, r, z_lr, w_gate2, b_gate, norm_g):
    B, T, _ = q.shape
    H, d, C = GLA_HEADS, GLA_HEAD_DIM, GLA_CHUNK
    N = T // C
    log_alpha = jax.nn.log_sigmoid((z_lr @ w_gate2 + b_gate).astype(jnp.float32)) / GLA_GATE_TAU

    def chunks(a):
        return a.astype(jnp.float32).reshape(B, N, C, H, d)

    qc = chunks(q) * d ** -0.5
    kc = chunks(k)
    vc = chunks(v)
    bcum = jnp.cumsum(chunks(log_alpha), axis=2)
    b_last = bcum[:, :, -1:]
    q_t = qc * jnp.exp(bcum)
    k_t = kc * jnp.exp(-bcum)
    k_end = kc * jnp.exp(b_last - bcum)
    causal = jnp.tril(jnp.ones((C, C), dtype=bool))
    att = jnp.where(causal, jnp.einsum('bnthd,bnshd->bnhts', q_t, k_t), 0.0)
    o_intra = jnp.einsum('bnhts,bnshv->bnthv', att, vc)
    upd = jnp.einsum('bnshk,bnshv->nbhkv', k_end, vc)
    decay = jnp.exp(b_last[:, :, 0]).transpose(1, 0, 2, 3)

    def step(state, xs):
        d_n, u_n = xs
        return d_n[..., None] * state + u_n, state

    _, s_in = lax.scan(step, jnp.zeros((B, H, d, d), jnp.float32), (decay, upd))
    o_inter = jnp.einsum('bnthk,nbhkv->bnthv', q_t, s_in)
    o = rms_norm((o_intra + o_inter).reshape(B, T, H, d), norm_g.reshape(H, d))
    return o.reshape(B, T, GLA_WIDTH) * jax.nn.silu(r.astype(jnp.float32))


def hybrid_layer(h, p_i, norm_mix_pre, w_in, nsa_cmp_w, nsa_cmp_pe, lru_conv_w, lru_conv_b,
                 lru_wa, lru_ba, lru_wi, lru_bi, lru_lambda, gla_w_gate2, gla_b_gate, gla_norm,
                 w_out, norm_mix_post, norm_mlp_pre, w_up, w_down, norm_mlp_post, w_ple_gate, w_ple):
    u = rms_norm(h, norm_mix_pre)
    proj = u @ w_in
    offsets = tuple(int(o) for o in np.cumsum(IN_SIZES)[:-1])
    (nsa_q, nsa_kv, nsa_g, lru_x, lru_y,
     gla_q, gla_k, gla_v, gla_r, gla_z) = jnp.split(proj, offsets, axis=-1)
    o_a = nsa_mixer(nsa_q, nsa_kv, nsa_g, nsa_cmp_w, nsa_cmp_pe)
    o_b = rglru_mixer(lru_x, lru_y, lru_conv_w, lru_conv_b, lru_wa, lru_ba, lru_wi, lru_bi, lru_lambda)
    o_c = gla_mixer(gla_q, gla_k, gla_v, gla_r, gla_z, gla_w_gate2, gla_b_gate, gla_norm)
    mix = jnp.concatenate([o_a.astype(h.dtype), o_b.astype(h.dtype), o_c.astype(h.dtype)], axis=-1)
    h = h + rms_norm(mix @ w_out, norm_mix_post)
    u = rms_norm(h, norm_mlp_pre)
    h = h + rms_norm(jnp.square(jax.nn.relu(u @ w_up)) @ w_down, norm_mlp_post)
    h = h + jax.nn.sigmoid(h @ w_ple_gate) * (p_i @ w_ple)
    return h


def setup_inputs(seed: int = 0) -> dict:
    key = jax.random.key(seed)
    ks = jax.random.split(key, 24)
    dk = NSA_HEAD_DIM
    nrm = jax.random.normal

    def gain(k):
        return 1.0 + 0.1 * nrm(k, (DEPTH, D_MODEL), jnp.float32)

    u = jax.random.uniform(ks[12], (DEPTH, LRU_WIDTH), jnp.float32, minval=0.9, maxval=0.999)
    s = u ** (1.0 / LRU_C)
    return {
        'x': nrm(ks[0], (BATCH, SEQ, D_MODEL), jnp.float32),
        'p': nrm(ks[1], (DEPTH, BATCH, SEQ, PLE_DIM), jnp.float32),
        'norm_mix_pre': gain(ks[2]),
        'w_in': nrm(ks[3], (DEPTH, D_MODEL, D_IN), jnp.float32) * D_MODEL ** -0.5,
        'nsa_cmp_w': nrm(ks[4], (DEPTH, 2, CMP_LEN * dk, dk), jnp.float32) * (CMP_LEN * dk) ** -0.5,
        'nsa_cmp_pe': 0.1 * nrm(ks[5], (DEPTH, 2, CMP_LEN, dk), jnp.float32),
        'lru_conv_w': nrm(ks[6], (DEPTH, CONV_WIDTH, LRU_WIDTH), jnp.float32) * CONV_WIDTH ** -0.5,
        'lru_conv_b': 0.01 * nrm(ks[7], (DEPTH, LRU_WIDTH), jnp.float32),
        'lru_wa': nrm(ks[8], (DEPTH, LRU_BLOCKS, LRU_BLOCK_DIM, LRU_BLOCK_DIM), jnp.float32) * LRU_BLOCK_DIM ** -0.5,
        'lru_ba': 0.01 * nrm(ks[9], (DEPTH, LRU_WIDTH), jnp.float32),
        'lru_wi': nrm(ks[10], (DEPTH, LRU_BLOCKS, LRU_BLOCK_DIM, LRU_BLOCK_DIM), jnp.float32) * LRU_BLOCK_DIM ** -0.5,
        'lru_bi': 0.01 * nrm(ks[11], (DEPTH, LRU_WIDTH), jnp.float32),
        'lru_lambda': jnp.log(s) - jnp.log1p(-s),
        'gla_w_gate2': nrm(ks[13], (DEPTH, GLA_GATE_RANK, GLA_WIDTH), jnp.float32) * GLA_GATE_RANK ** -0.5,
        'gla_b_gate': 0.01 * nrm(ks[14], (DEPTH, GLA_WIDTH), jnp.float32),
        'gla_norm': 1.0 + 0.1 * nrm(ks[15], (DEPTH, GLA_WIDTH), jnp.float32),
        'w_out': nrm(ks[16], (DEPTH, MIX_WIDTH, D_MODEL), jnp.float32) * MIX_WIDTH ** -0.5,
        'norm_mix_post': gain(ks[17]),
        'norm_mlp_pre': gain(ks[18]),
        'w_up': nrm(ks[19], (DEPTH, D_MODEL, D_FF), jnp.float32) * D_MODEL ** -0.5,
        'w_down': nrm(ks[20], (DEPTH, D_FF, D_MODEL), jnp.float32) * D_FF ** -0.5,
        'norm_mlp_post': gain(ks[21]),
        'w_ple_gate': nrm(ks[22], (DEPTH, D_MODEL, D_MODEL), jnp.float32) * D_MODEL ** -0.5,
        'w_ple': nrm(ks[23], (DEPTH, PLE_DIM, D_MODEL), jnp.float32) * PLE_DIM ** -0.5,
    }


def reference(x, p, norm_mix_pre, w_in, nsa_cmp_w, nsa_cmp_pe, lru_conv_w, lru_conv_b,
              lru_wa, lru_ba, lru_wi, lru_bi, lru_lambda, gla_w_gate2, gla_b_gate, gla_norm,
              w_out, norm_mix_post, norm_mlp_pre, w_up, w_down, norm_mlp_post, w_ple_gate, w_ple):
    h = x
    for i in range(DEPTH):
        h = hybrid_layer(h, p[i], norm_mix_pre[i], w_in[i], nsa_cmp_w[i], nsa_cmp_pe[i],
                         lru_conv_w[i], lru_conv_b[i], lru_wa[i], lru_ba[i], lru_wi[i], lru_bi[i],
                         lru_lambda[i], gla_w_gate2[i], gla_b_gate[i], gla_norm[i], w_out[i],
                         norm_mix_post[i], norm_mlp_pre[i], w_up[i], w_down[i], norm_mlp_post[i],
                         w_ple_gate[i], w_ple[i])
    return h
```

```cpp
#include <hip/hip_runtime.h>
#include <hip/hip_cooperative_groups.h>
#include <cstdio>
namespace cg = cooperative_groups;
namespace pg8 {
#define PG8_LAS __attribute__((address_space(3)))
typedef unsigned short bf16_t;
typedef short bf16x8 __attribute__((ext_vector_type(8)));
typedef float f32x4 __attribute__((ext_vector_type(4)));
typedef unsigned u32x4 __attribute__((ext_vector_type(4)));
constexpr int BM = 256, BK = 64, HALF = 128, HTB = HALF * BK * 2  , STAGE_BYTES = 8 * HTB, NXCD = 8, WGM = 8;

__host__ __device__ __forceinline__ int lds_byte(int r, int c) { const int st = (r >> 4) * 2 + (c >> 5), rr = r & 15, cc = c & 31, ob = rr * 64 + cc * 2; return st * 1024 + (ob ^ (((ob >> 9) & 1) << 5)); }
__host__ __device__ __forceinline__ void stage_rc(int b, int& R, int& C) { const int st = b / 1024, sb = b % 1024, swz = sb ^ (((sb >> 9) & 1) << 5); R = (st >> 1) * 16 + swz / 64; C = (st & 1) * 32 + (swz % 64) / 2; }
__host__ __device__ __forceinline__ int perm32(int rho) { const int n = rho >> 4, i = rho & 15; return 8 * (i >> 2) + 4 * n + (i & 3); }

struct Unit { int pm, pn; };
struct Gemm { const bf16_t* A; const bf16_t* Bt; int M, N, K; };

struct StaticOrder {
    int nM, nN, nwg, G, c;
    __host__ __device__ void init(int M, int N, int G_, int c_) { nM = M / BM; nN = N / BM; nwg = nM * nN; G = G_; c = c_; }
    __host__ __device__ bool next(int i, Unit& u) const {
        const long L = (long)i * G + c; if (L >= nwg) return false;
        int wgid = (int)L; { const int q = nwg / NXCD, r = nwg % NXCD, xcd = wgid % NXCD, off = wgid / NXCD; wgid = (xcd < r ? xcd * (q + 1) : r * (q + 1) + (xcd - r) * q) + off; }
        const int nig = WGM * nN, gid = wgid / nig, fm = gid * WGM, gsz = (nM - fm) < WGM ? (nM - fm) : WGM;
        u.pm = fm + ((wgid % nig) % gsz); u.pn = (wgid % nig) / gsz; return true;
    }
    __device__ __forceinline__ void a_ready(const Unit&) const {}
    __device__ __forceinline__ void done(const Unit&) const {}
};
struct CountedOrder : StaticOrder {
    const unsigned* ready; unsigned need; unsigned* tmo;
    __device__ __forceinline__ void a_ready(const Unit& u) const {
        if (threadIdx.x < 64) {
            const unsigned long long t0 = __builtin_amdgcn_s_memrealtime(); unsigned polls = 0;
            while ((unsigned)__builtin_amdgcn_readfirstlane(__hip_atomic_load(ready + 64 * u.pm, __ATOMIC_RELAXED, __HIP_MEMORY_SCOPE_AGENT)) < need) {
                if ((++polls & 255u) == 0u && __builtin_amdgcn_readfirstlane(__hip_atomic_load(tmo, __ATOMIC_RELAXED, __HIP_MEMORY_SCOPE_AGENT)) != 0u) break;
                if (__builtin_amdgcn_s_memrealtime() - t0 > 2000000ull) {
                    if (threadIdx.x == 0) { unsigned expect = 0u; __hip_atomic_compare_exchange_strong(tmo + 1, &expect, 0x600u | (unsigned)(u.pm & 0xff), __ATOMIC_RELAXED, __ATOMIC_RELAXED, __HIP_MEMORY_SCOPE_AGENT); __hip_atomic_store(tmo, 1u, __ATOMIC_RELAXED, __HIP_MEMORY_SCOPE_AGENT); }
                    break; }
                __builtin_amdgcn_s_sleep(2); }
            __builtin_amdgcn_fence(__ATOMIC_ACQUIRE, "agent");
            asm volatile("s_waitcnt vmcnt(0)" ::: "memory");
        }
#if !defined(BROKEN_HOOK_NO_BARRIER)
        asm volatile("" ::: "memory"); __builtin_amdgcn_s_barrier(); asm volatile("" ::: "memory");
#endif
    }
};

__device__ __forceinline__ unsigned cvt_pk_bf16(float lo, float hi) { unsigned r; asm volatile("v_cvt_pk_bf16_f32 %0, %1, %2" : "=v"(r) : "v"(lo), "v"(hi)); return r; }
typedef float f32x2 __attribute__((ext_vector_type(2)));
__device__ __forceinline__ f32x2 gelu_pk(f32x2 v) {
    const f32x2 av = __builtin_elementwise_abs(v), d = av * 0.2316418882f + 1.0f;
    f32x2 t; t.x = __builtin_amdgcn_rcpf(d.x); t.y = __builtin_amdgcn_rcpf(d.y);
    f32x2 q = t * 0.5307027145f + (-0.7265760135f); q = q * t + 0.7107068705f; q = q * t + (-0.142248368f); q = q * t + 0.127414796f; q = q * t;
    const f32x2 s = (v * v) * (-0.72134752044f);
    f32x2 e; e.x = __builtin_amdgcn_exp2f(s.x); e.y = __builtin_amdgcn_exp2f(s.y);
    const f32x2 m = v * (q * e), r = v - m;
    f32x2 o; o.x = v.x < 0.f ? m.x : r.x; o.y = v.y < 0.f ? m.y : r.y; return o;
}

struct EpiF32 {
    static constexpr bool PERM = false, AFTER_DRAIN = false;
    float* C; int ldc; const float* bias;
    __device__ __forceinline__ void operator()(const f32x4 (&acc)[2][2][4][2], const Unit& u, int wr, int wc, int fr, int fq) const {
        const int row0 = u.pm * BM + wr * 64 + fr, col0 = u.pn * BM + wc * 32 + 4 * fq;
        f32x4 bv[2][2];
#pragma unroll
        for (int bj = 0; bj < 2; ++bj)
#pragma unroll
            for (int n = 0; n < 2; ++n) bv[bj][n] = bias ? *(const f32x4*)(bias + col0 + bj * HALF + n * 16) : (f32x4){0.f, 0.f, 0.f, 0.f};
#pragma unroll
        for (int ai = 0; ai < 2; ++ai)
#pragma unroll
            for (int m = 0; m < 4; ++m) { float* rowp = C + (size_t)(row0 + ai * HALF + m * 16) * ldc + col0;
#pragma unroll
                for (int bj = 0; bj < 2; ++bj)
#pragma unroll
                    for (int n = 0; n < 2; ++n) *(f32x4*)(rowp + bj * HALF + n * 16) = acc[ai][bj][m][n] + bv[bj][n]; }
    }
};
template <int ACT  > struct EpiBf16 {
    static constexpr bool PERM = true, AFTER_DRAIN = false;
    bf16_t* O; int ldc; const float* bias; int split_cols; size_t split_stride;
    __device__ __forceinline__ void operator()(const f32x4 (&acc)[2][2][4][2], const Unit& u, int wr, int wc, int fr, int fq) const {
        const int row0 = u.pm * BM + wr * 64 + fr; int colt = u.pn * BM; bf16_t* base = O;
        if (split_cols) { const int t = colt / split_cols; base += (size_t)t * split_stride; colt -= t * split_cols; }
        const int col0 = colt + wc * 32 + 8 * fq, bcol0 = u.pn * BM + wc * 32 + 8 * fq;
        f32x4 bv[2][2];
#pragma unroll
        for (int bj = 0; bj < 2; ++bj)
#pragma unroll
            for (int n = 0; n < 2; ++n) bv[bj][n] = bias ? *(const f32x4*)(bias + bcol0 + bj * HALF + 4 * n) : (f32x4){0.f, 0.f, 0.f, 0.f};
#pragma unroll
        for (int ai = 0; ai < 2; ++ai)
#pragma unroll
            for (int m = 0; m < 4; ++m) { bf16_t* rowp = base + (size_t)(row0 + ai * HALF + m * 16) * ldc + col0;
#pragma unroll
                for (int bj = 0; bj < 2; ++bj) { f32x4 v0 = acc[ai][bj][m][0] + bv[bj][0], v1 = acc[ai][bj][m][1] + bv[bj][1];
                    if (ACT == 1) { f32x2 a = gelu_pk((f32x2){v0[0], v0[1]}), b = gelu_pk((f32x2){v0[2], v0[3]}), c = gelu_pk((f32x2){v1[0], v1[1]}), d = gelu_pk((f32x2){v1[2], v1[3]});
                        v0 = (f32x4){a.x, a.y, b.x, b.y}; v1 = (f32x4){c.x, c.y, d.x, d.y}; }
                    if (ACT == 2) {
#pragma unroll
                        for (int j = 0; j < 4; ++j) { v0[j] = 0.5f * v0[j] * (1.0f + erff(v0[j] * 0.70710678f)); v1[j] = 0.5f * v1[j] * (1.0f + erff(v1[j] * 0.70710678f)); } }
                    u32x4 w; w.x = cvt_pk_bf16(v0[0], v0[1]); w.y = cvt_pk_bf16(v0[2], v0[3]); w.z = cvt_pk_bf16(v1[0], v1[1]); w.w = cvt_pk_bf16(v1[2], v1[3]);
                    *(u32x4*)(rowp + bj * HALF) = w; } }
    }
};
template <class Epi, class Sched, bool STAMP = false>
__device__ __forceinline__ void gemm_phase(PG8_LAS unsigned char* lds, const Gemm g, const Sched& S, const Epi& E, unsigned long long* stamps) {
    int tid_ = threadIdx.x; asm volatile("" : "+v"(tid_)); int K_ = g.K; asm volatile("" : "+s"(K_));
    const int tid = tid_, wid = __builtin_amdgcn_readfirstlane(tid >> 6), lane = tid & 63, wr = wid >> 2, wc = wid & 3, fr = lane & 15, fq = lane >> 4;
    const int K = K_, nt = K / BK;
    int ts_lo = 0, ts_hi = 0, nts = 0; const unsigned long long rt_entry = STAMP ? (unsigned long long)wall_clock64() : 0ull;
#define PG8_STAMP() do { if (STAMP && wid == 0 && nts < 64) { const unsigned long long _c = (unsigned long long)clock64(); \
        ts_lo = (lane == nts) ? (int)(unsigned)_c : ts_lo; ts_hi = (lane == nts) ? (int)(unsigned)(_c >> 32) : ts_hi; ++nts; } } while (0)
    PG8_STAMP();
    unsigned voffA[2], voffB[2];
#pragma unroll
    for (int i = 0; i < 2; ++i) { int R, C; stage_rc(tid * 16 + i * 8192, R, C); const int Rb = Epi::PERM ? ((R & ~31) + perm32(R & 31)) : R;
        voffA[i] = (unsigned)(R * K + C) * 2u; voffB[i] = (unsigned)(Rb * K + C) * 2u; }
    const size_t kstep = (size_t)(BK * 2);
    const size_t hstep = (size_t)HALF * K * 2;
    const size_t tstep = 2 * hstep;
    const unsigned ldsw = (unsigned)wid * 1024u;
    const int aoff = lds_byte(wr * 64 + fr, fq * 8), boff = lds_byte(wc * 32 + fr, fq * 8);
#define PG8_SA(b, h) (((b) * 2 + (h)) * HTB)
#define PG8_SB(b, h) ((4 + (b) * 2 + (h)) * HTB)
#define PG8_STAGE(bufoff, gbase, voff) do { _Pragma("unroll") for (int _i = 0; _i < 2; ++_i) \
        __builtin_amdgcn_global_load_lds((const unsigned*)((const char*)(gbase) + (voff)[_i]), (PG8_LAS unsigned*)(lds + (bufoff) + ldsw + _i * 8192), 16, 0, 0); } while (0)
#define PG8_LDA(dst, b, h) do { _Pragma("unroll") for (int m = 0; m < 4; ++m) _Pragma("unroll") for (int k = 0; k < 2; ++k) dst[m][k] = *(const PG8_LAS bf16x8*)(lds + PG8_SA(b, h) + aoff + m * 2048 + k * 1024); } while (0)
#define PG8_LDB(dst, b, h) do { _Pragma("unroll") for (int n = 0; n < 2; ++n) _Pragma("unroll") for (int k = 0; k < 2; ++k) dst[n][k] = *(const PG8_LAS bf16x8*)(lds + PG8_SB(b, h) + boff + n * 2048 + k * 1024); } while (0)
#define PG8_MMA(ai, bj, At, Bt) do { __builtin_amdgcn_s_setprio(1); _Pragma("unroll") for (int m = 0; m < 4; ++m) _Pragma("unroll") for (int n = 0; n < 2; ++n) _Pragma("unroll") for (int k = 0; k < 2; ++k) \
        acc[ai][bj][m][n] = __builtin_amdgcn_mfma_f32_16x16x32_bf16(Bt[n][k], At[m][k], acc[ai][bj][m][n], 0, 0, 0); __builtin_amdgcn_s_setprio(0); } while (0)
#define PG8_WAIT_V(n) asm volatile("s_waitcnt vmcnt(" #n ")" ::: "memory")
#define PG8_WAIT_L(n) asm volatile("s_waitcnt lgkmcnt(" #n ")" ::: "memory")
#define PG8_BAR __builtin_amdgcn_s_barrier()
#define PG8_SCHED __builtin_amdgcn_sched_barrier(0)
    Unit cur, nxt; int ui = 0;
    if (!S.next(0, cur)) return;
    f32x4 acc[2][2][4][2];
#pragma unroll
    for (int a = 0; a < 2; ++a)
#pragma unroll
        for (int b = 0; b < 2; ++b)
#pragma unroll
            for (int m = 0; m < 4; ++m)
#pragma unroll
                for (int n = 0; n < 2; ++n) acc[a][b][m][n] = (f32x4){0.f, 0.f, 0.f, 0.f};
    bf16x8 At[4][2], B0[2][2], B1[2][2];
    const char* cA = (const char*)g.A + (size_t)cur.pm * tstep; const char* cB = (const char*)g.Bt + (size_t)cur.pn * tstep;
    S.a_ready(cur);
    PG8_STAGE(PG8_SB(0, 0), cB, voffB); PG8_STAGE(PG8_SA(0, 0), cA, voffA); PG8_STAGE(PG8_SB(0, 1), cB + hstep, voffB); PG8_STAGE(PG8_SA(0, 1), cA + hstep, voffA);
    if (wr == 1) PG8_BAR;
    PG8_WAIT_V(4); PG8_BAR;
    PG8_STAGE(PG8_SB(1, 0), cB + kstep, voffB); PG8_STAGE(PG8_SA(1, 0), cA + kstep, voffA); PG8_STAGE(PG8_SB(1, 1), cB + hstep + kstep, voffB);
    PG8_WAIT_V(6); PG8_BAR;
    PG8_STAMP();
    for (;;) {
        const bool has_next = S.next(ui + 1, nxt);
        const char* nA = has_next ? (const char*)g.A + (size_t)nxt.pm * tstep : cA; const char* nB = has_next ? (const char*)g.Bt + (size_t)nxt.pn * tstep : cB;
        for (int t = 0; t < nt; t += 2) {
            const bool last = (t == nt - 2);
            const char* a1 = cA + (size_t)(t + 1) * kstep;
            const char* a2 = last ? nA : cA + (size_t)(t + 2) * kstep; const char* b2 = last ? nB : cB + (size_t)(t + 2) * kstep;
            const char* a3 = a2 + kstep; const char* b3 = b2 + kstep;
            if (last && has_next) S.a_ready(nxt);
            PG8_LDB(B0, 0, 0); PG8_SCHED; PG8_LDA(At, 0, 0); PG8_STAGE(PG8_SA(1, 1), a1 + hstep, voffA);
            PG8_WAIT_L(8); PG8_BAR; PG8_WAIT_L(0); PG8_MMA(0, 0, At, B0); PG8_BAR; PG8_SCHED;
            PG8_LDB(B1, 0, 1); PG8_STAGE(PG8_SB(0, 0), b2, voffB);
            PG8_BAR; PG8_WAIT_L(0); PG8_MMA(0, 1, At, B1); PG8_BAR;
            PG8_LDA(At, 0, 1); PG8_STAGE(PG8_SA(0, 0), a2, voffA);
            PG8_BAR; PG8_WAIT_L(0); PG8_MMA(1, 0, At, B0); PG8_BAR; PG8_SCHED;
            PG8_STAGE(PG8_SB(0, 1), b2 + hstep, voffB);
            PG8_WAIT_V(6); PG8_BAR; PG8_MMA(1, 1, At, B1); PG8_BAR;
            PG8_LDB(B0, 1, 0); PG8_SCHED; PG8_LDA(At, 1, 0); PG8_STAGE(PG8_SA(0, 1), a2 + hstep, voffA);
            PG8_WAIT_L(8); PG8_BAR; PG8_WAIT_L(0); PG8_MMA(0, 0, At, B0); PG8_BAR; PG8_SCHED;
            PG8_LDB(B1, 1, 1); PG8_STAGE(PG8_SB(1, 0), b3, voffB);
            PG8_BAR; PG8_WAIT_L(0); PG8_MMA(0, 1, At, B1); PG8_BAR;
            PG8_LDA(At, 1, 1); PG8_STAGE(PG8_SA(1, 0), a3, voffA);
            PG8_BAR; PG8_WAIT_L(0); PG8_MMA(1, 0, At, B0); PG8_BAR; PG8_SCHED;
            PG8_STAGE(PG8_SB(1, 1), b3 + hstep, voffB);
            PG8_WAIT_V(6); PG8_BAR; PG8_MMA(1, 1, At, B1); PG8_BAR;
        }
        PG8_STAMP();
        if constexpr (!Epi::AFTER_DRAIN) { E(acc, cur, wr, wc, fr, fq); S.done(cur); }
        PG8_STAMP();
        if (!has_next) break;
#pragma unroll
        for (int a = 0; a < 2; ++a)
#pragma unroll
            for (int b = 0; b < 2; ++b)
#pragma unroll
                for (int m = 0; m < 4; ++m)
#pragma unroll
                    for (int n = 0; n < 2; ++n) acc[a][b][m][n] = (f32x4){0.f, 0.f, 0.f, 0.f};
        cur = nxt; cA = nA; cB = nB; ++ui;
    }
    PG8_WAIT_V(0);
    if (wr == 0) PG8_BAR;
    PG8_BAR;
    if constexpr (Epi::AFTER_DRAIN) { E.fused(acc, cur, wr, wc, fr, fq, lds, wid, lane); S.done(cur); }
    PG8_STAMP();
    if (STAMP && wid == 0) { stamps[lane] = lane < nts ? (((unsigned long long)(unsigned)ts_hi << 32) | (unsigned)ts_lo) : 0ull;
        if (lane == 62) stamps[62] = rt_entry; if (lane == 63) stamps[63] = (unsigned long long)wall_clock64(); }
#undef PG8_STAMP
#undef PG8_SA
#undef PG8_SB
#undef PG8_STAGE
#undef PG8_LDA
#undef PG8_LDB
#undef PG8_MMA
#undef PG8_WAIT_V
#undef PG8_WAIT_L
#undef PG8_BAR
#undef PG8_SCHED
}
}
namespace mk {
typedef unsigned short bf16_t;
typedef float f32x4 __attribute__((ext_vector_type(4)));
typedef unsigned u32x4 __attribute__((ext_vector_type(4)));
typedef unsigned u32x2 __attribute__((ext_vector_type(2)));
#define MK_LAS __attribute__((address_space(3)))

constexpr int NTHR = 512, LDS_BYTES = 131072;
constexpr int T_ = 4096, B_ = 2, M_ = 8192, D_ = 2048, DIN = 5696, DINP = 5888, DFF = 8192, PLE = 256;
constexpr int C_Q = 0, C_KV = 1024, C_G = 2560, C_LX = 2608, C_LY = 3120, C_GQ = 3632, C_GK = 4144, C_GV = 4656, C_GR = 5168, C_GZ = 5680;
constexpr int NCMP = 255;
constexpr float EPS = 1e-6f;
constexpr size_t MB = 1u << 20;
constexpr size_t WS_WIN = 0, WS_WOUT = 23 * MB, WS_WUP = 31 * MB, WS_WDN = 63 * MB, WS_WG = 95 * MB, WS_WP = 103 * MB,
                 WS_U = 104 * MB, WS_H = 136 * MB, WS_E = 200 * MB, WS_PB = 232 * MB,
                 WS_PROJ = 240 * MB, WS_MIX = 329 * MB, WS_LH = 361 * MB, WS_LP = 377 * MB, WS_GQT = 393 * MB, WS_GOI = 401 * MB,
                 WS_GUPD = 417 * MB, WS_GDEC = 449 * MB, WS_KC = 450 * MB, WS_VC = 450 * MB + 512 * 1024, WS_END = 451 * MB,
                 WS_ACT = 240 * MB, WS_Y = 384 * MB;

struct Params { const float* in[24]; float* out; unsigned char* ws; };

__device__ __forceinline__ bf16_t f2bf(float f) { unsigned u = __float_as_uint(f); u += 0x7FFFu + ((u >> 16) & 1u); return (bf16_t)(u >> 16); }
__device__ __forceinline__ float bf2f(bf16_t b) { return __uint_as_float(((unsigned)b) << 16); }
__device__ __forceinline__ unsigned pk2(float lo, float hi) { return (unsigned)f2bf(lo) | ((unsigned)f2bf(hi) << 16); }
__device__ __forceinline__ float bflo(unsigned u) { return __uint_as_float(u << 16); }
__device__ __forceinline__ float bfhi(unsigned u) { return __uint_as_float(u & 0xffff0000u); }
__device__ __forceinline__ float wave_sum(float v) {
#pragma unroll
    for (int o = 1; o < 64; o <<= 1) v += __shfl_xor(v, o);
    return v;
}
__device__ __forceinline__ int otid() { int t = threadIdx.x; asm volatile("" : "+v"(t)); return t; }
__device__ __forceinline__ float sigm(float x) { return 1.f / (1.f + expf(-x)); }

template <int ACT> struct EpiBf16P {
    static constexpr bool PERM = true, AFTER_DRAIN = false;
    bf16_t* O; int ldc; int ncols;
    __device__ __forceinline__ void operator()(const pg8::f32x4 (&acc)[2][2][4][2], const pg8::Unit& u, int wr, int wc, int fr, int fq) const {
        const int row0 = u.pm * 256 + wr * 64 + fr, col0 = u.pn * 256 + wc * 32 + 8 * fq;
#pragma unroll
        for (int ai = 0; ai < 2; ++ai)
#pragma unroll
            for (int m = 0; m < 4; ++m) { bf16_t* rowp = O + (size_t)(row0 + ai * 128 + m * 16) * ldc + col0;
#pragma unroll
                for (int bj = 0; bj < 2; ++bj) { pg8::f32x4 v0 = acc[ai][bj][m][0], v1 = acc[ai][bj][m][1];
                    if (ACT == 1) {
#pragma unroll
                        for (int j = 0; j < 4; ++j) { float a = fmaxf(v0[j], 0.f), b = fmaxf(v1[j], 0.f); v0[j] = a * a; v1[j] = b * b; } }
                    u32x4 w; w.x = pk2(v0[0], v0[1]); w.y = pk2(v0[2], v0[3]); w.z = pk2(v1[0], v1[1]); w.w = pk2(v1[2], v1[3]);
                    if (col0 + bj * 128 < ncols) *(u32x4*)(rowp + bj * 128) = w; } }
    }
};
struct EpiF32 {
    static constexpr bool PERM = false, AFTER_DRAIN = false;
    float* C; int ldc;
    __device__ __forceinline__ void operator()(const pg8::f32x4 (&acc)[2][2][4][2], const pg8::Unit& u, int wr, int wc, int fr, int fq) const {
        const int row0 = u.pm * 256 + wr * 64 + fr, col0 = u.pn * 256 + wc * 32 + 4 * fq;
#pragma unroll
        for (int ai = 0; ai < 2; ++ai)
#pragma unroll
            for (int m = 0; m < 4; ++m) { float* rowp = C + (size_t)(row0 + ai * 128 + m * 16) * ldc + col0;
#pragma unroll
                for (int bj = 0; bj < 2; ++bj)
#pragma unroll
                    for (int n = 0; n < 2; ++n) *(pg8::f32x4*)(rowp + bj * 128 + n * 16) = acc[ai][bj][m][n]; }
    }
};
struct EpiPle {
    static constexpr bool PERM = false, AFTER_DRAIN = false;
    float* out; const float* h2; const bf16_t* e; int ldc;
    __device__ __forceinline__ void operator()(const pg8::f32x4 (&acc)[2][2][4][2], const pg8::Unit& u, int wr, int wc, int fr, int fq) const {
        const int row0 = u.pm * 256 + wr * 64 + fr, col0 = u.pn * 256 + wc * 32 + 4 * fq;
#pragma unroll
        for (int ai = 0; ai < 2; ++ai)
#pragma unroll
            for (int m = 0; m < 4; ++m) { const size_t ro = (size_t)(row0 + ai * 128 + m * 16) * ldc + col0;
#pragma unroll
                for (int bj = 0; bj < 2; ++bj)
#pragma unroll
                    for (int n = 0; n < 2; ++n) { const size_t o = ro + bj * 128 + n * 16;
                        const pg8::f32x4 hv = *(const pg8::f32x4*)(h2 + o); const u32x2 ev = *(const u32x2*)(e + o); const pg8::f32x4 a = acc[ai][bj][m][n];
                        pg8::f32x4 r; r[0] = hv[0] + sigm(a[0]) * bflo(ev.x); r[1] = hv[1] + sigm(a[1]) * bfhi(ev.x);
                        r[2] = hv[2] + sigm(a[2]) * bflo(ev.y); r[3] = hv[3] + sigm(a[3]) * bfhi(ev.y);
                        *(pg8::f32x4*)(out + o) = r; } }
    }
};
template <class Epi> __device__ __forceinline__ void run_gemm(unsigned char* smem, const bf16_t* A, const bf16_t* Bt, int M, int N, int K, const Epi& E) {
    pg8::Gemm g{A, Bt, M, N, K}; pg8::StaticOrder S; S.init(M, N, (int)gridDim.x, (int)blockIdx.x);
    pg8::gemm_phase<Epi, pg8::StaticOrder, false>((PG8_LAS unsigned char*)smem, g, S, E, nullptr);
}

__device__ __forceinline__ void transpose_item(const float* __restrict__ W, int K, int N, bf16_t* __restrict__ WT, float* scr, int item, int lane) {
    const int nblk = N / 32, kb = item / nblk, nb = item % nblk, k0 = 64 * kb, n0 = 32 * nb;
#pragma unroll 8
    for (int i = 0; i < 32; ++i) { const int kk = 2 * i + (lane >> 5); scr[kk * 33 + (lane & 31)] = W[(size_t)(k0 + kk) * N + n0 + (lane & 31)]; }
    asm volatile("s_waitcnt lgkmcnt(0)" ::: "memory");
    const int c = lane & 7;
#pragma unroll
    for (int j = 0; j < 4; ++j) { const int n = (lane >> 3) + 8 * j; const float* s = scr + (8 * c) * 33 + n;
        u32x4 o; o.x = pk2(s[0 * 33], s[1 * 33]); o.y = pk2(s[2 * 33], s[3 * 33]); o.z = pk2(s[4 * 33], s[5 * 33]); o.w = pk2(s[6 * 33], s[7 * 33]);
        *(u32x4*)(WT + (size_t)(n0 + n) * K + k0 + 8 * c) = o; }
    asm volatile("s_waitcnt lgkmcnt(0)" ::: "memory");
}
__device__ __forceinline__ void convert_weights(const Params& p, int L, unsigned char* smem) {
    const int tid = otid(), lane = tid & 63, wave = tid >> 6;
    float* scr = (float*)smem + wave * (64 * 33);
    const int gw = blockIdx.x * 8 + wave, NGW = gridDim.x * 8;
    unsigned char* ws = p.ws;
    constexpr int I_IN = 32 * 178, I_OUT = 32 * 64, I_UP = 32 * 256, I_DN = 128 * 64, I_G = 32 * 64, I_P = 4 * 64;
    constexpr int NIT = I_IN + I_OUT + I_UP + I_DN + I_G + I_P;
    for (int it = gw; it < NIT; it += NGW) {
        int r = it;
        if (r < I_IN) { transpose_item(p.in[3] + (size_t)L * D_ * DIN, D_, DIN, (bf16_t*)(ws + WS_WIN), scr, r, lane); continue; } r -= I_IN;
        if (r < I_OUT) { transpose_item(p.in[16] + (size_t)L * D_ * D_, D_, D_, (bf16_t*)(ws + WS_WOUT), scr, r, lane); continue; } r -= I_OUT;
        if (r < I_UP) { transpose_item(p.in[19] + (size_t)L * D_ * DFF, D_, DFF, (bf16_t*)(ws + WS_WUP), scr, r, lane); continue; } r -= I_UP;
        if (r < I_DN) { transpose_item(p.in[20] + (size_t)L * DFF * D_, DFF, D_, (bf16_t*)(ws + WS_WDN), scr, r, lane); continue; } r -= I_DN;
        if (r < I_G) { transpose_item(p.in[22] + (size_t)L * D_ * D_, D_, D_, (bf16_t*)(ws + WS_WG), scr, r, lane); continue; } r -= I_G;
        transpose_item(p.in[23] + (size_t)L * PLE * D_, PLE, D_, (bf16_t*)(ws + WS_WP), scr, r, lane);
    }
    u32x4* z = (u32x4*)(ws + WS_WIN + (size_t)DIN * D_ * 2); const int nz = (DINP - DIN) * D_ * 2 / 16;
    for (int i = blockIdx.x * NTHR + tid; i < nz; i += gridDim.x * NTHR) z[i] = (u32x4){0u, 0u, 0u, 0u};
}

__device__ __forceinline__ void row_phase(const float* __restrict__ h_in, const float* __restrict__ y, const float* __restrict__ g_post, float* __restrict__ h_out,
                                          const float* __restrict__ g_pre, bf16_t* __restrict__ u_out) {
    const int tid = otid(), lane = tid & 63, wave = tid >> 6;
    for (int row = blockIdx.x * 8 + wave; row < M_; row += gridDim.x * 8) {
        const f32x4* hp = (const f32x4*)(h_in + (size_t)row * D_) + lane;
        f32x4 hv[8];
#pragma unroll
        for (int j = 0; j < 8; ++j) hv[j] = hp[64 * j];
        if (y) {
            const f32x4* yp = (const f32x4*)(y + (size_t)row * D_) + lane; f32x4 yv[8]; float ss = 0.f;
#pragma unroll
            for (int j = 0; j < 8; ++j) { yv[j] = yp[64 * j]; ss += yv[j][0] * yv[j][0] + yv[j][1] * yv[j][1] + yv[j][2] * yv[j][2] + yv[j][3] * yv[j][3]; }
            const float r = rsqrtf(wave_sum(ss) * (1.f / D_) + EPS);
            f32x4* op = (f32x4*)(h_out + (size_t)row * D_) + lane;
#pragma unroll
            for (int j = 0; j < 8; ++j) { const f32x4 g = ((const f32x4*)g_post)[lane + 64 * j]; hv[j] = hv[j] + yv[j] * r * g; op[64 * j] = hv[j]; }
        }
        float r2 = 1.f;
        if (g_pre) { float ss = 0.f;
#pragma unroll
            for (int j = 0; j < 8; ++j) ss += hv[j][0] * hv[j][0] + hv[j][1] * hv[j][1] + hv[j][2] * hv[j][2] + hv[j][3] * hv[j][3];
            r2 = rsqrtf(wave_sum(ss) * (1.f / D_) + EPS); }
        u32x2* up = (u32x2*)(u_out + (size_t)row * D_) + lane;
#pragma unroll
        for (int j = 0; j < 8; ++j) { f32x4 v = hv[j] * r2; if (g_pre) v = v * ((const f32x4*)g_pre)[lane + 64 * j];
            u32x2 o; o.x = pk2(v[0], v[1]); o.y = pk2(v[2], v[3]); up[64 * j] = o; }
    }
}
__device__ __forceinline__ float dot64(const float (&q)[64], const bf16_t* __restrict__ kp) {
    const u32x4* p4 = (const u32x4*)kp; float s = 0.f;
#pragma unroll
    for (int c = 0; c < 8; ++c) { const u32x4 v = p4[c];
        s += q[8 * c + 0] * bflo(v.x) + q[8 * c + 1] * bfhi(v.x) + q[8 * c + 2] * bflo(v.y) + q[8 * c + 3] * bfhi(v.y)
           + q[8 * c + 4] * bflo(v.z) + q[8 * c + 5] * bfhi(v.z) + q[8 * c + 6] * bflo(v.w) + q[8 * c + 7] * bfhi(v.w); }
    return s;
}
__device__ __forceinline__ void axpy64(float (&o)[64], float sc, float pw, const bf16_t* __restrict__ vp) {
    const u32x4* p4 = (const u32x4*)vp;
#pragma unroll
    for (int c = 0; c < 8; ++c) { const u32x4 v = p4[c];
        o[8 * c + 0] = o[8 * c + 0] * sc + pw * bflo(v.x); o[8 * c + 1] = o[8 * c + 1] * sc + pw * bfhi(v.x);
        o[8 * c + 2] = o[8 * c + 2] * sc + pw * bflo(v.y); o[8 * c + 3] = o[8 * c + 3] * sc + pw * bfhi(v.y);
        o[8 * c + 4] = o[8 * c + 4] * sc + pw * bflo(v.z); o[8 * c + 5] = o[8 * c + 5] * sc + pw * bfhi(v.z);
        o[8 * c + 6] = o[8 * c + 6] * sc + pw * bflo(v.w); o[8 * c + 7] = o[8 * c + 7] * sc + pw * bfhi(v.w); }
}

__device__ __forceinline__ void compress_item(const Params& p, int L, int w, int lane) {
    const int kv = w / 2040, r1 = w % 2040, b = r1 / 1020, r2 = r1 % 1020, n = r2 >> 2, g = r2 & 3;
    const float* W = p.in[4] + ((size_t)L * 2 + kv) * 2048 * 64;
    const float* pe = p.in[5] + ((size_t)L * 2 + kv) * 2048;
    const bf16_t* src = (const bf16_t*)(p.ws + WS_PROJ) + ((size_t)(b * T_ + 16 * n)) * DIN + C_KV + kv * 256 + g * 64;
    float acc = 0.f;
    for (int l = 0; l < 32; ++l) { const bf16_t* row = src + (size_t)l * DIN;
#pragma unroll 8
        for (int dd = 0; dd < 64; ++dd) { const float a = bf2f(row[dd]) + pe[l * 64 + dd]; acc += a * W[(size_t)(l * 64 + dd) * 64 + lane]; } }
    bf16_t* dst = (bf16_t*)(p.ws + (kv ? WS_VC : WS_KC));
    dst[((size_t)(b * NCMP + n) * 4 + g) * 64 + lane] = f2bf(acc);
}

__device__ __forceinline__ void nsa_naive_item(const Params& p, int item, unsigned char* smem) {
    const int tid = otid(), lane = tid & 63;
    const int b = item >> 7, t = (item & 127) * 32 + (tid >> 4), hq = tid & 15, g = hq >> 2, hh = hq & 3;
    const bf16_t* proj = (const bf16_t*)(p.ws + WS_PROJ);
    const bf16_t* prow = proj + (size_t)(b * T_ + t) * DIN;
    const bf16_t* kc = (const bf16_t*)(p.ws + WS_KC); const bf16_t* vc = (const bf16_t*)(p.ws + WS_VC);
    float* impp = (float*)smem + (tid >> 2) * 64;
    float q[64];
    { const u32x4* qp = (const u32x4*)(prow + C_Q + hq * 64);
#pragma unroll
      for (int c = 0; c < 8; ++c) { const u32x4 v = qp[c]; q[8*c+0] = 0.125f * bflo(v.x); q[8*c+1] = 0.125f * bfhi(v.x); q[8*c+2] = 0.125f * bflo(v.y); q[8*c+3] = 0.125f * bfhi(v.y);
          q[8*c+4] = 0.125f * bflo(v.z); q[8*c+5] = 0.125f * bfhi(v.z); q[8*c+6] = 0.125f * bflo(v.w); q[8*c+7] = 0.125f * bfhi(v.w); } }
    const float slope = exp2f(-0.5f * (float)(hq + 1));
    const float g0 = sigm(bf2f(prow[C_G + hq * 3 + 0])), g1 = sigm(bf2f(prow[C_G + hq * 3 + 1])), g2 = sigm(bf2f(prow[C_G + hq * 3 + 2]));
    float outv[64];
#pragma unroll
    for (int d = 0; d < 64; ++d) outv[d] = 0.f;
    if (hh == 0) { for (int j = 0; j < 64; ++j) impp[j] = 0.f; }
    const int nvalid = (t >= 31) ? ((t - 31) / 16 + 1) : 0;
    {
        float m = -1e30f, l = 0.f;
        for (int n = 0; n < nvalid; ++n) { const float s = dot64(q, kc + ((size_t)(b * NCMP + n) * 4 + g) * 64) - slope * (float)(t - (16 * n + 31));
            const float mn = fmaxf(m, s); l = l * expf(m - mn) + expf(s - mn); m = mn; }
        const float il = (l > 0.f) ? 1.f / l : 0.f;
        for (int n = 0; n < nvalid; ++n) { const size_t ko = ((size_t)(b * NCMP + n) * 4 + g) * 64;
            const float s = dot64(q, kc + ko) - slope * (float)(t - (16 * n + 31));
            const float pw = expf(s - m) * il;
            axpy64(outv, 1.f, pw * g0, vc + ko);
            float ps = pw; ps += __shfl_xor(ps, 1); ps += __shfl_xor(ps, 2);
            if (hh == 0) { impp[n >> 2] += ps; if ((n & 3) == 3 && (n >> 2) < 63) impp[(n >> 2) + 1] += ps; } }
    }
    const int tb = t >> 6;
    unsigned mlo = 0u, mhi = 0u;
    if (hh == 0) {
        unsigned long long mask;
        if (tb < 16) mask = (1ull << (tb + 1)) - 1ull;
        else { mask = 1ull | (1ull << tb) | (1ull << (tb - 1));
            for (int r = 0; r < 13; ++r) { int best = 1; float bv = -1.f;
                for (int j = 1; j <= tb - 2; ++j) { const float v = impp[j]; if (!((mask >> j) & 1ull) && v > bv) { bv = v; best = j; } }
                mask |= 1ull << best; } }
        mlo = (unsigned)mask; mhi = (unsigned)(mask >> 32);
    }
    mlo = __shfl(mlo, lane & ~3); mhi = __shfl(mhi, lane & ~3);
    const unsigned long long mask = ((unsigned long long)mhi << 32) | mlo;
    {
        float m = -1e30f, l = 0.f;
        const bf16_t* kb = proj + (size_t)(b * T_) * DIN + C_KV + 2 * 256 + g * 64; const bf16_t* vb = kb + 256;
        for (int j = 0; j <= tb; ++j) { if (!((mask >> j) & 1ull)) continue;
            const int pend = min(t, 64 * j + 63);
            for (int pos = 64 * j; pos <= pend; ++pos) { const float s = dot64(q, kb + (size_t)pos * DIN) - slope * (float)(t - pos);
                const float mn = fmaxf(m, s); l = l * expf(m - mn) + expf(s - mn); m = mn; } }
        const float f = g1 / l;
        for (int j = 0; j <= tb; ++j) { if (!((mask >> j) & 1ull)) continue;
            const int pend = min(t, 64 * j + 63);
            for (int pos = 64 * j; pos <= pend; ++pos) { const float s = dot64(q, kb + (size_t)pos * DIN) - slope * (float)(t - pos);
                axpy64(outv, 1.f, f * expf(s - m), vb + (size_t)pos * DIN); } }
    }
    {
        float m = -1e30f, l = 0.f;
        const bf16_t* kb = proj + (size_t)(b * T_) * DIN + C_KV + 4 * 256 + g * 64; const bf16_t* vb = kb + 256;
        const int p0 = max(0, t - 511);
        for (int pos = p0; pos <= t; ++pos) { const float s = dot64(q, kb + (size_t)pos * DIN) - slope * (float)(t - pos);
            const float mn = fmaxf(m, s); l = l * expf(m - mn) + expf(s - mn); m = mn; }
        const float f = g2 / l;
        for (int pos = p0; pos <= t; ++pos) { const float s = dot64(q, kb + (size_t)pos * DIN) - slope * (float)(t - pos);
            axpy64(outv, 1.f, f * expf(s - m), vb + (size_t)pos * DIN); }
    }
    u32x4* op = (u32x4*)((bf16_t*)(p.ws + WS_MIX) + (size_t)(b * T_ + t) * D_ + hq * 64);
#pragma unroll
    for (int c = 0; c < 8; ++c) { u32x4 w; w.x = pk2(outv[8*c], outv[8*c+1]); w.y = pk2(outv[8*c+2], outv[8*c+3]); w.z = pk2(outv[8*c+4], outv[8*c+5]); w.w = pk2(outv[8*c+6], outv[8*c+7]); op[c] = w; }
}

__device__ __forceinline__ void lru_prep_item(const Params& p, int L, int item, unsigned char* smem) {
    const int c = otid(), b = item >> 6, n = item & 63;
    float* xs = (float*)smem;
    const bf16_t* proj = (const bf16_t*)(p.ws + WS_PROJ);
    const float lam = p.in[12][L * 512 + c]; const float sp = log1pf(expf(-lam));
    float cw[4];
#pragma unroll
    for (int k = 0; k < 4; ++k) cw[k] = p.in[6][(L * 4 + k) * 512 + c];
    const float cb = p.in[7][L * 512 + c], ba = p.in[9][L * 512 + c], bi = p.in[11][L * 512 + c];
    const int blk = c >> 6, d = c & 63;
    const float* wa = p.in[8] + (size_t)L * 8 * 4096 + blk * 4096 + d; const float* wi = p.in[10] + (size_t)L * 8 * 4096 + blk * 4096 + d;
    float* hl = (float*)(p.ws + WS_LH); float* pp = (float*)(p.ws + WS_LP);
    float h = 0.f, P = 1.f;
    const int t0 = n * 64;
    float x0 = (t0 >= 3) ? bf2f(proj[(size_t)(b * T_ + t0 - 3) * DIN + C_LX + c]) : 0.f;
    float x1 = (t0 >= 2) ? bf2f(proj[(size_t)(b * T_ + t0 - 2) * DIN + C_LX + c]) : 0.f;
    float x2 = (t0 >= 1) ? bf2f(proj[(size_t)(b * T_ + t0 - 1) * DIN + C_LX + c]) : 0.f;
    for (int tt = 0; tt < 64; ++tt) { const int t = t0 + tt;
        const float x3 = bf2f(proj[(size_t)(b * T_ + t) * DIN + C_LX + c]);
        const float xc = cb + cw[0] * x0 + cw[1] * x1 + cw[2] * x2 + cw[3] * x3;
        x0 = x1; x1 = x2; x2 = x3;
        float* xb = xs + (tt & 1) * 512; xb[c] = xc;
        __syncthreads();
        float ra = ba, ri = bi;
#pragma unroll 8
        for (int k = 0; k < 64; ++k) { const float xv = xb[blk * 64 + k]; ra += xv * wa[k * 64]; ri += xv * wi[k * 64]; }
        const float r = sigm(ra), ig = sigm(ri);
        const float log_a = -8.f * r * sp; const float a = expf(log_a);
        const float u = sqrtf(-expm1f(2.f * log_a)) * (ig * xc);
        h = a * h + u; P *= a;
        hl[(size_t)(b * T_ + t) * 512 + c] = h; pp[(size_t)(b * T_ + t) * 512 + c] = P;
    }
    __syncthreads();
}
__device__ __forceinline__ float gelu_tanh(float x) { const float u = 0.7978845608028654f * (x + 0.044715f * x * x * x); return 0.5f * x * (1.f + tanhf(u)); }
__device__ __forceinline__ void lru_out_item(const Params& p, int item) {
    const int c = otid(), b = item >> 6, n = item & 63;
    const float* hl = (const float*)(p.ws + WS_LH); const float* pp = (const float*)(p.ws + WS_LP);
    const bf16_t* proj = (const bf16_t*)(p.ws + WS_PROJ); bf16_t* mix = (bf16_t*)(p.ws + WS_MIX);
    float carry = 0.f;
    for (int m = 0; m < n; ++m) { const size_t o = (size_t)(b * T_ + m * 64 + 63) * 512 + c; carry = pp[o] * carry + hl[o]; }
    for (int tt = 0; tt < 64; ++tt) { const size_t row = (size_t)(b * T_ + n * 64 + tt);
        const float h = hl[row * 512 + c] + pp[row * 512 + c] * carry;
        const float y = bf2f(proj[row * DIN + C_LY + c]);
        mix[row * D_ + 1024 + c] = f2bf(h * gelu_tanh(y)); }
}

constexpr int GP = 130;
__device__ __forceinline__ void gla_prep_item(const Params& p, int L, int item, unsigned char* smem) {
    const int tid = otid(), b = item >> 8, n = (item >> 2) & 63, h = item & 3;
    float* Bc = (float*)smem;
    bf16_t* Qt = (bf16_t*)(smem + 32768);
    bf16_t* Kt = Qt + 64 * GP; bf16_t* Ke = Kt + 64 * GP; bf16_t* Vs = Ke + 64 * GP;
    float* Att = (float*)(smem + 99328);
    float* zs = (float*)(smem + 115968);
    float* segt = (float*)(smem + 120064);
    const bf16_t* proj = (const bf16_t*)(p.ws + WS_PROJ);
    const size_t row0 = (size_t)(b * T_ + n * 64);
    for (int i = tid; i < 1024; i += NTHR) { const int t = i >> 4, r = i & 15; zs[i] = bf2f(proj[(row0 + t) * DIN + C_GZ + r]); }
    __syncthreads();
    { const int c = tid & 127, seg = tid >> 7; float w2c[16];
#pragma unroll
      for (int r = 0; r < 16; ++r) w2c[r] = p.in[13][((size_t)L * 16 + r) * 512 + h * 128 + c];
      const float bg = p.in[14][L * 512 + h * 128 + c]; float run = 0.f;
      for (int i = 0; i < 16; ++i) { const int t = seg * 16 + i; float x = bg;
#pragma unroll
          for (int r = 0; r < 16; ++r) x += zs[t * 16 + r] * w2c[r];
          const float ls = fminf(x, 0.f) - log1pf(expf(-fabsf(x)));
          run += ls * (1.f / 16.f); Bc[t * 128 + c] = run; }
      segt[seg * 128 + c] = run; }
    __syncthreads();
    { const int c = tid & 127, seg = tid >> 7; float off = 0.f; for (int s = 0; s < seg; ++s) off += segt[s * 128 + c];
      if (seg > 0) for (int i = 0; i < 16; ++i) Bc[(seg * 16 + i) * 128 + c] += off; }
    __syncthreads();
    bf16_t* gqt = (bf16_t*)(p.ws + WS_GQT); float* gdec = (float*)(p.ws + WS_GDEC);
    for (int i = tid; i < 8192; i += NTHR) { const int t = i >> 7, c = i & 127; const bf16_t* pr = proj + (row0 + t) * DIN + h * 128 + c;
        const float bc = Bc[t * 128 + c], bl = Bc[63 * 128 + c];
        const float qv = bf2f(pr[C_GQ]) * 0.08838834764831845f * expf(bc), kv = bf2f(pr[C_GK]);
        const bf16_t qb = f2bf(qv);
        Qt[t * GP + c] = qb; Kt[t * GP + c] = f2bf(kv * expf(-bc)); Ke[t * GP + c] = f2bf(kv * expf(bl - bc)); Vs[t * GP + c] = pr[C_GV];
        gqt[(row0 + t) * 512 + h * 128 + c] = qb;
        if (t == 63) gdec[(size_t)((b * 64 + n) * 4 + h) * 128 + c] = expf(bl); }
    __syncthreads();
    { const int t = tid >> 3, sg = tid & 7; const unsigned* qr = (const unsigned*)(Qt + t * GP);
      for (int i = 0; i < 8; ++i) { const int s = sg * 8 + i; float a = 0.f;
          if (s <= t) { const unsigned* kr = (const unsigned*)(Kt + s * GP);
#pragma unroll 8
              for (int k = 0; k < 64; ++k) { const unsigned qa = qr[k], ka = kr[k]; a += bflo(qa) * bflo(ka) + bfhi(qa) * bfhi(ka); } }
          Att[t * 65 + s] = a; } }
    __syncthreads();
    { const int v = tid & 127, tg = tid >> 7; float* goi = (float*)(p.ws + WS_GOI);
      for (int i = 0; i < 16; ++i) { const int t = tg * 16 + i; float a = 0.f;
          for (int s = 0; s <= t; ++s) a += Att[t * 65 + s] * bf2f(Vs[s * GP + v]);
          goi[(row0 + t) * 512 + h * 128 + v] = a; } }
    { const int k = tid & 127, vg = tid >> 7; float acc[32];
#pragma unroll
      for (int i = 0; i < 32; ++i) acc[i] = 0.f;
      for (int s = 0; s < 64; ++s) { const float ke = bf2f(Ke[s * GP + k]); const unsigned* vr = (const unsigned*)(Vs + s * GP + vg * 32);
#pragma unroll
          for (int i = 0; i < 16; ++i) { const unsigned vv = vr[i]; acc[2 * i] += bflo(vv) * ke; acc[2 * i + 1] += bfhi(vv) * ke; } }
      float* gupd = (float*)(p.ws + WS_GUPD) + (size_t)((b * 64 + n) * 4 + h) * 16384;
#pragma unroll
      for (int i = 0; i < 32; ++i) gupd[(vg * 32 + i) * 128 + k] = acc[i]; }
    __syncthreads();
}
__device__ __forceinline__ void gla_scan(const Params& p) {
    float* gupd = (float*)(p.ws + WS_GUPD); const float* gdec = (const float*)(p.ws + WS_GDEC);
    const int tid = otid();
    for (int e = blockIdx.x * NTHR + tid; e < 131072; e += gridDim.x * NTHR) {
        const int b = e >> 16, h = (e >> 14) & 3, vk = e & 16383, k = e & 127; float S = 0.f;
#pragma unroll 8
        for (int n = 0; n < 64; ++n) { const size_t bi = (size_t)((b * 64 + n) * 4 + h);
            const float u = gupd[bi * 16384 + vk], d = gdec[bi * 128 + k]; gupd[bi * 16384 + vk] = S; S = d * S + u; }
    }
}
__device__ __forceinline__ void gla_out_item(const Params& p, int L, int item, unsigned char* smem) {
    const int tid = otid(), lane = tid & 63, wave = tid >> 6, b = item >> 8, n = (item >> 2) & 63, h = item & 3;
    float* ST = (float*)smem;
    float* Qs = (float*)(smem + 66048);
    const float* gupd = (const float*)(p.ws + WS_GUPD) + (size_t)((b * 64 + n) * 4 + h) * 16384;
    const bf16_t* gqt = (const bf16_t*)(p.ws + WS_GQT); const float* goi = (const float*)(p.ws + WS_GOI);
    const bf16_t* proj = (const bf16_t*)(p.ws + WS_PROJ); bf16_t* mix = (bf16_t*)(p.ws + WS_MIX);
    const size_t row0 = (size_t)(b * T_ + n * 64);
    for (int i = tid; i < 16384; i += NTHR) ST[(i >> 7) * 129 + (i & 127)] = gupd[i];
    for (int i = tid; i < 8192; i += NTHR) Qs[i] = bf2f(gqt[(row0 + (i >> 7)) * 512 + h * 128 + (i & 127)]);
    __syncthreads();
    const float gn0 = p.in[15][L * 512 + h * 128 + lane], gn1 = p.in[15][L * 512 + h * 128 + lane + 64];
    for (int ti = 0; ti < 8; ++ti) { const int t = wave * 8 + ti; const float* qr = Qs + t * 128; const float* s0 = ST + lane * 129; const float* s1 = ST + (lane + 64) * 129;
        float o0 = 0.f, o1 = 0.f;
#pragma unroll 8
        for (int k = 0; k < 128; ++k) { const float qv = qr[k]; o0 += qv * s0[k]; o1 += qv * s1[k]; }
        o0 += goi[(row0 + t) * 512 + h * 128 + lane]; o1 += goi[(row0 + t) * 512 + h * 128 + lane + 64];
        const float r = rsqrtf(wave_sum(o0 * o0 + o1 * o1) * (1.f / 128.f) + EPS);
        const float r0 = bf2f(proj[(row0 + t) * DIN + C_GR + h * 128 + lane]), r1 = bf2f(proj[(row0 + t) * DIN + C_GR + h * 128 + lane + 64]);
        mix[(row0 + t) * D_ + 1536 + h * 128 + lane] = f2bf(o0 * r * gn0 * (r0 * sigm(r0)));
        mix[(row0 + t) * D_ + 1536 + h * 128 + lane + 64] = f2bf(o1 * r * gn1 * (r1 * sigm(r1))); }
    __syncthreads();
}
__global__ void __launch_bounds__(512, 2) mega(Params p) {
    extern __shared__ __attribute__((aligned(16))) unsigned char smem[];
    cg::grid_group grid = cg::this_grid();
    unsigned char* ws = p.ws;
    const int G = gridDim.x, bx = blockIdx.x;
    bf16_t* U = (bf16_t*)(ws + WS_U); float* H = (float*)(ws + WS_H); bf16_t* E = (bf16_t*)(ws + WS_E); bf16_t* PB = (bf16_t*)(ws + WS_PB);
    bf16_t* PROJ = (bf16_t*)(ws + WS_PROJ); bf16_t* MIX = (bf16_t*)(ws + WS_MIX); bf16_t* ACT = (bf16_t*)(ws + WS_ACT); float* Y = (float*)(ws + WS_Y);
    { const int tid = otid(); const f32x4* src = (const f32x4*)p.in[1]; u32x2* dst = (u32x2*)PB; const int n4 = 2 * M_ * PLE / 4;
      for (int i = bx * NTHR + tid; i < n4; i += G * NTHR) { const f32x4 v = src[i]; u32x2 o; o.x = pk2(v[0], v[1]); o.y = pk2(v[2], v[3]); dst[i] = o; } }
#pragma unroll 1
    for (int L = 0; L < 2; ++L) {
        convert_weights(p, L, smem);
        row_phase(L == 0 ? p.in[0] : H, nullptr, nullptr, nullptr, p.in[2] + L * D_, U);
        grid.sync();
        run_gemm(smem, U, (const bf16_t*)(ws + WS_WIN), M_, DINP, D_, EpiBf16P<0>{PROJ, DIN, DIN});
        grid.sync();
        for (int it = bx; it < 128; it += G) lru_prep_item(p, L, it, smem);
        for (int it = bx; it < 512; it += G) gla_prep_item(p, L, it, smem);
        { const int tid = otid(), wave = tid >> 6, lane = tid & 63; for (int w = bx * 8 + wave; w < 4080; w += G * 8) compress_item(p, L, w, lane); }
        grid.sync();
        gla_scan(p);
        for (int it = bx; it < 256; it += G) nsa_naive_item(p, it, smem);
        for (int it = bx; it < 128; it += G) lru_out_item(p, it);
        grid.sync();
        for (int it = bx; it < 512; it += G) gla_out_item(p, L, it, smem);
        grid.sync();
        run_gemm(smem, MIX, (const bf16_t*)(ws + WS_WOUT), M_, D_, D_, EpiF32{Y, D_});
        run_gemm(smem, PB + (size_t)L * M_ * PLE, (const bf16_t*)(ws + WS_WP), M_, D_, PLE, EpiBf16P<0>{E, D_, D_});
        grid.sync();
        row_phase(L == 0 ? p.in[0] : H, Y, p.in[17] + L * D_, H, p.in[18] + L * D_, U);
        grid.sync();
        run_gemm(smem, U, (const bf16_t*)(ws + WS_WUP), M_, DFF, D_, EpiBf16P<1>{ACT, DFF, DFF});
        grid.sync();
        run_gemm(smem, ACT, (const bf16_t*)(ws + WS_WDN), M_, D_, DFF, EpiF32{Y, D_});
        grid.sync();
        row_phase(H, Y, p.in[21] + L * D_, H, nullptr, U);
        grid.sync();
        run_gemm(smem, U, (const bf16_t*)(ws + WS_WG), M_, D_, D_, EpiPle{L == 1 ? p.out : H, H, E, D_});
        grid.sync();
    }
}
}

extern "C" void kernel_launch(void* const* d_in, const int* in_sizes, int n_in, void* d_out, int out_size, void* d_ws, size_t ws_size, hipStream_t stream) {
    static int grid = 0;
    if (grid == 0) {
        if (n_in != 24 || ws_size < mk::WS_END) { fprintf(stderr, "kernel_launch: unexpected n_in %d / ws %zu\n", n_in, ws_size); grid = -1; return; }
        int dev = 0, cus = 0, per = 0;
        hipGetDevice(&dev); hipDeviceGetAttribute(&cus, hipDeviceAttributeMultiprocessorCount, dev);
        if (hipFuncSetAttribute((const void*)mk::mega, hipFuncAttributeMaxDynamicSharedMemorySize, mk::LDS_BYTES) != hipSuccess) fprintf(stderr, "kernel_launch: hipFuncSetAttribute failed\n");
        if (hipOccupancyMaxActiveBlocksPerMultiprocessor(&per, (const void*)mk::mega, mk::NTHR, mk::LDS_BYTES) != hipSuccess || per < 1) { fprintf(stderr, "kernel_launch: occupancy query says %d\n", per); per = 1; }
        (void)hipGetLastError();
        grid = cus;
    }
    if (grid < 0) return;
    mk::Params p{};
    for (int i = 0; i < 24; ++i) p.in[i] = (const float*)d_in[i];
    p.out = (float*)d_out; p.ws = (unsigned char*)d_ws;
    void* args[] = {&p};
    hipError_t e = hipLaunchCooperativeKernel((const void*)mk::mega, dim3(grid), dim3(mk::NTHR), args, mk::LDS_BYTES, stream);
    if (e != hipSuccess) fprintf(stderr, "kernel_launch: cooperative launch failed: %s (grid %d)\n", hipGetErrorString(e), grid);
}
```

```cpp
#include <hip/hip_runtime.h>
#include <hip/hip_cooperative_groups.h>
#include <cstdio>
namespace cg = cooperative_groups;
namespace pg8 {
#define PG8_LAS __attribute__((address_space(3)))
typedef unsigned short bf16_t;
typedef short bf16x8 __attribute__((ext_vector_type(8)));
typedef float f32x4 __attribute__((ext_vector_type(4)));
typedef unsigned u32x4 __attribute__((ext_vector_type(4)));
constexpr int BM = 256, BK = 64, HALF = 128, HTB = HALF * BK * 2  , STAGE_BYTES = 8 * HTB, NXCD = 8, WGM = 8;

__host__ __device__ __forceinline__ int lds_byte(int r, int c) { const int st = (r >> 4) * 2 + (c >> 5), rr = r & 15, cc = c & 31, ob = rr * 64 + cc * 2; return st * 1024 + (ob ^ (((ob >> 9) & 1) << 5)); }
__host__ __device__ __forceinline__ void stage_rc(int b, int& R, int& C) { const int st = b / 1024, sb = b % 1024, swz = sb ^ (((sb >> 9) & 1) << 5); R = (st >> 1) * 16 + swz / 64; C = (st & 1) * 32 + (swz % 64) / 2; }
__host__ __device__ __forceinline__ int perm32(int rho) { const int n = rho >> 4, i = rho & 15; return 8 * (i >> 2) + 4 * n + (i & 3); }

struct Unit { int pm, pn; };
struct Gemm { const bf16_t* A; const bf16_t* Bt; int M, N, K; };

struct StaticOrder {
    int nM, nN, nwg, G, c;
    __host__ __device__ void init(int M, int N, int G_, int c_) { nM = M / BM; nN = N / BM; nwg = nM * nN; G = G_; c = c_; }
    __host__ __device__ bool next(int i, Unit& u) const {
        const long L = (long)i * G + c; if (L >= nwg) return false;
        int wgid = (int)L; { const int q = nwg / NXCD, r = nwg % NXCD, xcd = wgid % NXCD, off = wgid / NXCD; wgid = (xcd < r ? xcd * (q + 1) : r * (q + 1) + (xcd - r) * q) + off; }
        const int nig = WGM * nN, gid = wgid / nig, fm = gid * WGM, gsz = (nM - fm) < WGM ? (nM - fm) : WGM;
        u.pm = fm + ((wgid % nig) % gsz); u.pn = (wgid % nig) / gsz; return true;
    }
    __device__ __forceinline__ void a_ready(const Unit&) const {}
    __device__ __forceinline__ void done(const Unit&) const {}
};
struct CountedOrder : StaticOrder {
    const unsigned* ready; unsigned need; unsigned* tmo;
    __device__ __forceinline__ void a_ready(const Unit& u) const {
        if (threadIdx.x < 64) {
            const unsigned long long t0 = __builtin_amdgcn_s_memrealtime(); unsigned polls = 0;
            while ((unsigned)__builtin_amdgcn_readfirstlane(__hip_atomic_load(ready + 64 * u.pm, __ATOMIC_RELAXED, __HIP_MEMORY_SCOPE_AGENT)) < need) {
                if ((++polls & 255u) == 0u && __builtin_amdgcn_readfirstlane(__hip_atomic_load(tmo, __ATOMIC_RELAXED, __HIP_MEMORY_SCOPE_AGENT)) != 0u) break;
                if (__builtin_amdgcn_s_memrealtime() - t0 > 2000000ull) {
                    if (threadIdx.x == 0) { unsigned expect = 0u; __hip_atomic_compare_exchange_strong(tmo + 1, &expect, 0x600u | (unsigned)(u.pm & 0xff), __ATOMIC_RELAXED, __ATOMIC_RELAXED, __HIP_MEMORY_SCOPE_AGENT); __hip_atomic_store(tmo, 1u, __ATOMIC_RELAXED, __HIP_MEMORY_SCOPE_AGENT); }
                    break; }
                __builtin_amdgcn_s_sleep(2); }
            __builtin_amdgcn_fence(__ATOMIC_ACQUIRE, "agent");
            asm volatile("s_waitcnt vmcnt(0)" ::: "memory");
        }
#if !defined(BROKEN_HOOK_NO_BARRIER)
        asm volatile("" ::: "memory"); __builtin_amdgcn_s_barrier(); asm volatile("" ::: "memory");
#endif
    }
};

__device__ __forceinline__ unsigned cvt_pk_bf16(float lo, float hi) { unsigned r; asm volatile("v_cvt_pk_bf16_f32 %0, %1, %2" : "=v"(r) : "v"(lo), "v"(hi)); return r; }
typedef float f32x2 __attribute__((ext_vector_type(2)));
__device__ __forceinline__ f32x2 gelu_pk(f32x2 v) {
    const f32x2 av = __builtin_elementwise_abs(v), d = av * 0.2316418882f + 1.0f;
    f32x2 t; t.x = __builtin_amdgcn_rcpf(d.x); t.y = __builtin_amdgcn_rcpf(d.y);
    f32x2 q = t * 0.5307027145f + (-0.7265760135f); q = q * t + 0.7107068705f; q = q * t + (-0.142248368f); q = q * t + 0.127414796f; q = q * t;
    const f32x2 s = (v * v) * (-0.72134752044f);
    f32x2 e; e.x = __builtin_amdgcn_exp2f(s.x); e.y = __builtin_amdgcn_exp2f(s.y);
    const f32x2 m = v * (q * e), r = v - m;
    f32x2 o; o.x = v.x < 0.f ? m.x : r.x; o.y = v.y < 0.f ? m.y : r.y; return o;
}

struct EpiF32 {
    static constexpr bool PERM = false, AFTER_DRAIN = false;
    float* C; int ldc; const float* bias;
    __device__ __forceinline__ void operator()(const f32x4 (&acc)[2][2][4][2], const Unit& u, int wr, int wc, int fr, int fq) const {
        const int row0 = u.pm * BM + wr * 64 + fr, col0 = u.pn * BM + wc * 32 + 4 * fq;
        f32x4 bv[2][2];
#pragma unroll
        for (int bj = 0; bj < 2; ++bj)
#pragma unroll
            for (int n = 0; n < 2; ++n) bv[bj][n] = bias ? *(const f32x4*)(bias + col0 + bj * HALF + n * 16) : (f32x4){0.f, 0.f, 0.f, 0.f};
#pragma unroll
        for (int ai = 0; ai < 2; ++ai)
#pragma unroll
            for (int m = 0; m < 4; ++m) { float* rowp = C + (size_t)(row0 + ai * HALF + m * 16) * ldc + col0;
#pragma unroll
                for (int bj = 0; bj < 2; ++bj)
#pragma unroll
                    for (int n = 0; n < 2; ++n) *(f32x4*)(rowp + bj * HALF + n * 16) = acc[ai][bj][m][n] + bv[bj][n]; }
    }
};
template <int ACT  > struct EpiBf16 {
    static constexpr bool PERM = true, AFTER_DRAIN = false;
    bf16_t* O; int ldc; const float* bias; int split_cols; size_t split_stride;
    __device__ __forceinline__ void operator()(const f32x4 (&acc)[2][2][4][2], const Unit& u, int wr, int wc, int fr, int fq) const {
        const int row0 = u.pm * BM + wr * 64 + fr; int colt = u.pn * BM; bf16_t* base = O;
        if (split_cols) { const int t = colt / split_cols; base += (size_t)t * split_stride; colt -= t * split_cols; }
        const int col0 = colt + wc * 32 + 8 * fq, bcol0 = u.pn * BM + wc * 32 + 8 * fq;
        f32x4 bv[2][2];
#pragma unroll
        for (int bj = 0; bj < 2; ++bj)
#pragma unroll
            for (int n = 0; n < 2; ++n) bv[bj][n] = bias ? *(const f32x4*)(bias + bcol0 + bj * HALF + 4 * n) : (f32x4){0.f, 0.f, 0.f, 0.f};
#pragma unroll
        for (int ai = 0; ai < 2; ++ai)
#pragma unroll
            for (int m = 0; m < 4; ++m) { bf16_t* rowp = base + (size_t)(row0 + ai * HALF + m * 16) * ldc + col0;
#pragma unroll
                for (int bj = 0; bj < 2; ++bj) { f32x4 v0 = acc[ai][bj][m][0] + bv[bj][0], v1 = acc[ai][bj][m][1] + bv[bj][1];
                    if (ACT == 1) { f32x2 a = gelu_pk((f32x2){v0[0], v0[1]}), b = gelu_pk((f32x2){v0[2], v0[3]}), c = gelu_pk((f32x2){v1[0], v1[1]}), d = gelu_pk((f32x2){v1[2], v1[3]});
                        v0 = (f32x4){a.x, a.y, b.x, b.y}; v1 = (f32x4){c.x, c.y, d.x, d.y}; }
                    if (ACT == 2) {
#pragma unroll
                        for (int j = 0; j < 4; ++j) { v0[j] = 0.5f * v0[j] * (1.0f + erff(v0[j] * 0.70710678f)); v1[j] = 0.5f * v1[j] * (1.0f + erff(v1[j] * 0.70710678f)); } }
                    u32x4 w; w.x = cvt_pk_bf16(v0[0], v0[1]); w.y = cvt_pk_bf16(v0[2], v0[3]); w.z = cvt_pk_bf16(v1[0], v1[1]); w.w = cvt_pk_bf16(v1[2], v1[3]);
                    *(u32x4*)(rowp + bj * HALF) = w; } }
    }
};
template <class Epi, class Sched, bool STAMP = false>
__device__ __forceinline__ void gemm_phase(PG8_LAS unsigned char* lds, const Gemm g, const Sched& S, const Epi& E, unsigned long long* stamps) {
    int tid_ = threadIdx.x; asm volatile("" : "+v"(tid_)); int K_ = g.K; asm volatile("" : "+s"(K_));
    const int tid = tid_, wid = __builtin_amdgcn_readfirstlane(tid >> 6), lane = tid & 63, wr = wid >> 2, wc = wid & 3, fr = lane & 15, fq = lane >> 4;
    const int K = K_, nt = K / BK;
    int ts_lo = 0, ts_hi = 0, nts = 0; const unsigned long long rt_entry = STAMP ? (unsigned long long)wall_clock64() : 0ull;
#define PG8_STAMP() do { if (STAMP && wid == 0 && nts < 64) { const unsigned long long _c = (unsigned long long)clock64(); \
        ts_lo = (lane == nts) ? (int)(unsigned)_c : ts_lo; ts_hi = (lane == nts) ? (int)(unsigned)(_c >> 32) : ts_hi; ++nts; } } while (0)
    PG8_STAMP();
    unsigned voffA[2], voffB[2];
#pragma unroll
    for (int i = 0; i < 2; ++i) { int R, C; stage_rc(tid * 16 + i * 8192, R, C); const int Rb = Epi::PERM ? ((R & ~31) + perm32(R & 31)) : R;
        voffA[i] = (unsigned)(R * K + C) * 2u; voffB[i] = (unsigned)(Rb * K + C) * 2u; }
    const size_t kstep = (size_t)(BK * 2);
    const size_t hstep = (size_t)HALF * K * 2;
    const size_t tstep = 2 * hstep;
    const unsigned ldsw = (unsigned)wid * 1024u;
    const int aoff = lds_byte(wr * 64 + fr, fq * 8), boff = lds_byte(wc * 32 + fr, fq * 8);
#define PG8_SA(b, h) (((b) * 2 + (h)) * HTB)
#define PG8_SB(b, h) ((4 + (b) * 2 + (h)) * HTB)
#define PG8_STAGE(bufoff, gbase, voff) do { _Pragma("unroll") for (int _i = 0; _i < 2; ++_i) \
        __builtin_amdgcn_global_load_lds((const unsigned*)((const char*)(gbase) + (voff)[_i]), (PG8_LAS unsigned*)(lds + (bufoff) + ldsw + _i * 8192), 16, 0, 0); } while (0)
#define PG8_LDA(dst, b, h) do { _Pragma("unroll") for (int m = 0; m < 4; ++m) _Pragma("unroll") for (int k = 0; k < 2; ++k) dst[m][k] = *(const PG8_LAS bf16x8*)(lds + PG8_SA(b, h) + aoff + m * 2048 + k * 1024); } while (0)
#define PG8_LDB(dst, b, h) do { _Pragma("unroll") for (int n = 0; n < 2; ++n) _Pragma("unroll") for (int k = 0; k < 2; ++k) dst[n][k] = *(const PG8_LAS bf16x8*)(lds + PG8_SB(b, h) + boff + n * 2048 + k * 1024); } while (0)
#define PG8_MMA(ai, bj, At, Bt) do { __builtin_amdgcn_s_setprio(1); _Pragma("unroll") for (int m = 0; m < 4; ++m) _Pragma("unroll") for (int n = 0; n < 2; ++n) _Pragma("unroll") for (int k = 0; k < 2; ++k) \
        acc[ai][bj][m][n] = __builtin_amdgcn_mfma_f32_16x16x32_bf16(Bt[n][k], At[m][k], acc[ai][bj][m][n], 0, 0, 0); __builtin_amdgcn_s_setprio(0); } while (0)
#define PG8_WAIT_V(n) asm volatile("s_waitcnt vmcnt(" #n ")" ::: "memory")
#define PG8_WAIT_L(n) asm volatile("s_waitcnt lgkmcnt(" #n ")" ::: "memory")
#define PG8_BAR __builtin_amdgcn_s_barrier()
#define PG8_SCHED __builtin_amdgcn_sched_barrier(0)
    Unit cur, nxt; int ui = 0;
    if (!S.next(0, cur)) return;
    f32x4 acc[2][2][4][2];
#pragma unroll
    for (int a = 0; a < 2; ++a)
#pragma unroll
        for (int b = 0; b < 2; ++b)
#pragma unroll
            for (int m = 0; m < 4; ++m)
#pragma unroll
                for (int n = 0; n < 2; ++n) acc[a][b][m][n] = (f32x4){0.f, 0.f, 0.f, 0.f};
    bf16x8 At[4][2], B0[2][2], B1[2][2];
    const char* cA = (const char*)g.A + (size_t)cur.pm * tstep; const char* cB = (const char*)g.Bt + (size_t)cur.pn * tstep;
    S.a_ready(cur);
    PG8_STAGE(PG8_SB(0, 0), cB, voffB); PG8_STAGE(PG8_SA(0, 0), cA, voffA); PG8_STAGE(PG8_SB(0, 1), cB + hstep, voffB); PG8_STAGE(PG8_SA(0, 1), cA + hstep, voffA);
    if (wr == 1) PG8_BAR;
    PG8_WAIT_V(4); PG8_BAR;
    PG8_STAGE(PG8_SB(1, 0), cB + kstep, voffB); PG8_STAGE(PG8_SA(1, 0), cA + kstep, voffA); PG8_STAGE(PG8_SB(1, 1), cB + hstep + kstep, voffB);
    PG8_WAIT_V(6); PG8_BAR;
    PG8_STAMP();
    for (;;) {
        const bool has_next = S.next(ui + 1, nxt);
        const char* nA = has_next ? (const char*)g.A + (size_t)nxt.pm * tstep : cA; const char* nB = has_next ? (const char*)g.Bt + (size_t)nxt.pn * tstep : cB;
        for (int t = 0; t < nt; t += 2) {
            const bool last = (t == nt - 2);
            const char* a1 = cA + (size_t)(t + 1) * kstep;
            const char* a2 = last ? nA : cA + (size_t)(t + 2) * kstep; const char* b2 = last ? nB : cB + (size_t)(t + 2) * kstep;
            const char* a3 = a2 + kstep; const char* b3 = b2 + kstep;
            if (last && has_next) S.a_ready(nxt);
            PG8_LDB(B0, 0, 0); PG8_SCHED; PG8_LDA(At, 0, 0); PG8_STAGE(PG8_SA(1, 1), a1 + hstep, voffA);
            PG8_WAIT_L(8); PG8_BAR; PG8_WAIT_L(0); PG8_MMA(0, 0, At, B0); PG8_BAR; PG8_SCHED;
            PG8_LDB(B1, 0, 1); PG8_STAGE(PG8_SB(0, 0), b2, voffB);
            PG8_BAR; PG8_WAIT_L(0); PG8_MMA(0, 1, At, B1); PG8_BAR;
            PG8_LDA(At, 0, 1); PG8_STAGE(PG8_SA(0, 0), a2, voffA);
            PG8_BAR; PG8_WAIT_L(0); PG8_MMA(1, 0, At, B0); PG8_BAR; PG8_SCHED;
            PG8_STAGE(PG8_SB(0, 1), b2 + hstep, voffB);
            PG8_WAIT_V(6); PG8_BAR; PG8_MMA(1, 1, At, B1); PG8_BAR;
            PG8_LDB(B0, 1, 0); PG8_SCHED; PG8_LDA(At, 1, 0); PG8_STAGE(PG8_SA(0, 1), a2 + hstep, voffA);
            PG8_WAIT_L(8); PG8_BAR; PG8_WAIT_L(0); PG8_MMA(0, 0, At, B0); PG8_BAR; PG8_SCHED;
            PG8_LDB(B1, 1, 1); PG8_STAGE(PG8_SB(1, 0), b3, voffB);
            PG8_BAR; PG8_WAIT_L(0); PG8_MMA(0, 1, At, B1); PG8_BAR;
            PG8_LDA(At, 1, 1); PG8_STAGE(PG8_SA(1, 0), a3, voffA);
            PG8_BAR; PG8_WAIT_L(0); PG8_MMA(1, 0, At, B0); PG8_BAR; PG8_SCHED;
            PG8_STAGE(PG8_SB(1, 1), b3 + hstep, voffB);
            PG8_WAIT_V(6); PG8_BAR; PG8_MMA(1, 1, At, B1); PG8_BAR;
        }
        PG8_STAMP();
        if constexpr (!Epi::AFTER_DRAIN) { E(acc, cur, wr, wc, fr, fq); S.done(cur); }
        PG8_STAMP();
        if (!has_next) break;
#pragma unroll
        for (int a = 0; a < 2; ++a)
#pragma unroll
            for (int b = 0; b < 2; ++b)
#pragma unroll
                for (int m = 0; m < 4; ++m)
#pragma unroll
                    for (int n = 0; n < 2; ++n) acc[a][b][m][n] = (f32x4){0.f, 0.f, 0.f, 0.f};
        cur = nxt; cA = nA; cB = nB; ++ui;
    }
    PG8_WAIT_V(0);
    if (wr == 0) PG8_BAR;
    PG8_BAR;
    if constexpr (Epi::AFTER_DRAIN) { E.fused(acc, cur, wr, wc, fr, fq, lds, wid, lane); S.done(cur); }
    PG8_STAMP();
    if (STAMP && wid == 0) { stamps[lane] = lane < nts ? (((unsigned long long)(unsigned)ts_hi << 32) | (unsigned)ts_lo) : 0ull;
        if (lane == 62) stamps[62] = rt_entry; if (lane == 63) stamps[63] = (unsigned long long)wall_clock64(); }
#undef PG8_STAMP
#undef PG8_SA
#undef PG8_SB
#undef PG8_STAGE
#undef PG8_LDA
#undef PG8_LDB
#undef PG8_MMA
#undef PG8_WAIT_V
#undef PG8_WAIT_L
#undef PG8_BAR
#undef PG8_SCHED
}
}
#define XB_TMO      128
#define XB_XCNT(j)  (256  + 64 * (j))
#define XB_XSUB(j)  (1280 + 64 * (j))
#define XB_XGEN(j)  (2304 + 64 * (j))
#define XB_TOP      3328
#define XB_TOPGEN   3392
#define XCD_BAR_WORDS 3456
#define XB_SPIN_CAP (1u << 18)
#define XB_LAS __attribute__((address_space(3)))

__device__ __forceinline__ unsigned xb_ld(unsigned* p)              { return __hip_atomic_load(p, __ATOMIC_RELAXED, __HIP_MEMORY_SCOPE_AGENT); }
__device__ __forceinline__ unsigned xb_add(unsigned* p, unsigned v) { return __hip_atomic_fetch_add(p, v, __ATOMIC_RELAXED, __HIP_MEMORY_SCOPE_AGENT); }
__device__ __forceinline__ unsigned xb_xcc_id() { return (unsigned)__builtin_amdgcn_s_getreg((3 << 11) | 20) & 0xFu; }
#define XB_SPIN(cond, bar) do { unsigned _sp = 0; while (cond) { __builtin_amdgcn_s_sleep(1); \
    if ((++_sp & 255u) == 0u) { if (xb_ld(&(bar)[XB_TMO])) break; if (_sp > XB_SPIN_CAP) { atomicAdd(&(bar)[XB_TMO], 1u); break; } } } } while (0)

struct XcdBarrier {
    unsigned* bar; unsigned x;
    volatile XB_LAS unsigned* st;
};

__device__ __forceinline__ XcdBarrier xcd_barrier_post(unsigned* bar, volatile XB_LAS unsigned* st) {
    XcdBarrier b; b.bar = bar; b.x = xb_xcc_id(); b.st = st;
    if (threadIdx.x == 0) (void)xb_add(&bar[XB_XCNT(b.x)], 1u);
    return b;
}
__device__ __forceinline__ void xcd_barrier_complete(unsigned* bar, unsigned x, unsigned& nloc, unsigned& nx) {
    const unsigned G = gridDim.x * gridDim.y * gridDim.z;
    unsigned sum, cnt, mine, sp = 0u;
    for (;;) {
        sum = 0u; cnt = 0u; mine = 0u;
#pragma unroll
        for (unsigned j = 0; j < 16; ++j) { const unsigned c = xb_ld(&bar[XB_XCNT(j)]); sum += c; cnt += (c > 0u) ? 1u : 0u; mine = (j == x) ? c : mine; }
        if (sum == G) break;
        __builtin_amdgcn_s_sleep(1);
        if ((++sp & 255u) == 0u) { if (xb_ld(&bar[XB_TMO])) break; if (sp > XB_SPIN_CAP) { atomicAdd(&bar[XB_TMO], 1u); break; } }
    }
    nloc = mine > 0u ? mine : 1u; nx = cnt > 0u ? cnt : 1u;
}

__device__ __forceinline__ void xcd_barrier(const XcdBarrier& b) {
    asm volatile("s_waitcnt vmcnt(0)" ::: "memory");
    __syncthreads();
    if (threadIdx.x == 0) {
        unsigned* bar = b.bar;
        __builtin_amdgcn_s_waitcnt(0);
        unsigned nloc = b.st[0], nx = b.st[1];
        if (nloc == 0u) { xcd_barrier_complete(bar, b.x, nloc, nx); b.st[0] = nloc; b.st[1] = nx; }
        const unsigned old = xb_add(&bar[XB_XSUB(b.x)], 1u);
        const unsigned gen = old / nloc;
        if (old + 1u == (gen + 1u) * nloc) {
            __builtin_amdgcn_fence(__ATOMIC_RELEASE, "agent");
            asm volatile("s_waitcnt vmcnt(0)" ::: "memory");
            const unsigned og = xb_add(&bar[XB_TOP], 1u);
            const unsigned tg = og / nx;
            if (og + 1u == (tg + 1u) * nx) xb_add(&bar[XB_TOPGEN], 1u);
            else XB_SPIN(xb_ld(&bar[XB_TOPGEN]) == tg, bar);
            __builtin_amdgcn_fence(__ATOMIC_ACQUIRE, "agent");
            xb_add(&bar[XB_XGEN(b.x)], 1u);
            asm volatile("s_waitcnt vmcnt(0)" ::: "memory");
        } else {
            XB_SPIN(xb_ld(&bar[XB_XGEN(b.x)]) == gen, bar);
            __builtin_amdgcn_fence(__ATOMIC_ACQUIRE, "agent");
            asm volatile("s_waitcnt vmcnt(0)" ::: "memory");
        }
    }
    __syncthreads();
}

namespace mk {
typedef unsigned short bf16_t;
typedef float f32x4 __attribute__((ext_vector_type(4)));
typedef unsigned u32x4 __attribute__((ext_vector_type(4)));
typedef unsigned u32x2 __attribute__((ext_vector_type(2)));
#define MK_LAS __attribute__((address_space(3)))

constexpr int NTHR = 512, LDS_BYTES = 147456;
constexpr int T_ = 4096, B_ = 2, M_ = 8192, D_ = 2048, DIN = 5696, DINP = 5888, DFF = 8192, PLE = 256;
constexpr int C_Q = 0, C_KV = 1024, C_G = 2560, C_LX = 2608, C_LY = 3120, C_GQ = 3632, C_GK = 4144, C_GV = 4656, C_GR = 5168, C_GZ = 5680;
constexpr int NCMP = 255;
constexpr float EPS = 1e-6f;
constexpr size_t MB = 1u << 20;
constexpr size_t WS_WIN = 0, WS_WOUT = 23 * MB, WS_WUP = 31 * MB, WS_WDN = 63 * MB, WS_WG = 95 * MB, WS_WP = 103 * MB,
                 WS_U = 104 * MB, WS_H = 136 * MB, WS_E = 200 * MB, WS_PB = 232 * MB,
                 WS_PROJ = 240 * MB, WS_MIX = 329 * MB, WS_LH = 361 * MB, WS_LP = 377 * MB, WS_GQT = 393 * MB, WS_GOI = 401 * MB,
                 WS_GUPD = 417 * MB, WS_GDEC = 449 * MB, WS_KC = 450 * MB, WS_VC = 450 * MB + 512 * 1024, WS_WCT = 451 * MB, WS_LWT = 451 * MB + 512 * 1024, WS_PEB = 451 * MB + 768 * 1024, WS_BAR = 452 * MB, WS_VST = 453 * MB, WS_VWT = 457 * MB, WS_VCT = 461 * MB, WS_END = 462 * MB,
                 WS_ACT = 240 * MB, WS_Y = 384 * MB;

struct Params { const float* in[24]; float* out; unsigned char* ws; };
typedef const __attribute__((address_space(4))) Params* KP;
__device__ __forceinline__ KP kparams() { KP k = (KP)__builtin_amdgcn_kernarg_segment_ptr(); asm volatile("" : "+s"(k)); return k; }

__device__ __forceinline__ float bf2f(bf16_t b) { return __uint_as_float(((unsigned)b) << 16); }
typedef float f32x2n __attribute__((ext_vector_type(2)));
typedef __bf16 bf16x2n __attribute__((ext_vector_type(2)));
__device__ __forceinline__ unsigned pk2(float lo, float hi) { const f32x2n v = {lo, hi}; return __builtin_bit_cast(unsigned, __builtin_convertvector(v, bf16x2n)); }
__device__ __forceinline__ bf16_t f2bf(float f) { return (bf16_t)(pk2(f, f) & 0xffffu); }
__device__ __forceinline__ float bflo(unsigned u) { return __uint_as_float(u << 16); }
__device__ __forceinline__ float bfhi(unsigned u) { return __uint_as_float(u & 0xffff0000u); }
__device__ __forceinline__ float wave_sum(float v) {
#pragma unroll
    for (int o = 1; o < 64; o <<= 1) v += __shfl_xor(v, o);
    return v;
}
__device__ __forceinline__ int otid() { int t = threadIdx.x; asm volatile("" : "+v"(t)); return t; }
__device__ __forceinline__ unsigned char* osm(unsigned char* s) { unsigned off = 0; asm volatile("" : "+s"(off)); return s + off; }
__device__ __forceinline__ float fexp(float x) { return __builtin_amdgcn_exp2f(x * 1.4426950408889634f); }
__device__ __forceinline__ float sigm(float x) { return __builtin_amdgcn_rcpf(1.f + fexp(-x)); }

template <int ACT> struct EpiBf16P {
    static constexpr bool PERM = true, AFTER_DRAIN = false;
    bf16_t* O; int ldc; int ncols;
    __device__ __forceinline__ void operator()(const pg8::f32x4 (&acc)[2][2][4][2], const pg8::Unit& u, int wr, int wc, int fr, int fq) const {
        const int row0 = u.pm * 256 + wr * 64 + fr, col0 = u.pn * 256 + wc * 32 + 8 * fq;
#pragma unroll
        for (int ai = 0; ai < 2; ++ai)
#pragma unroll
            for (int m = 0; m < 4; ++m) { bf16_t* rowp = O + (size_t)(row0 + ai * 128 + m * 16) * ldc + col0;
#pragma unroll
                for (int bj = 0; bj < 2; ++bj) { pg8::f32x4 v0 = acc[ai][bj][m][0], v1 = acc[ai][bj][m][1];
                    if (ACT == 1) {
#pragma unroll
                        for (int j = 0; j < 4; ++j) { float a = fmaxf(v0[j], 0.f), b = fmaxf(v1[j], 0.f); v0[j] = a * a; v1[j] = b * b; } }
                    u32x4 w; w.x = pk2(v0[0], v0[1]); w.y = pk2(v0[2], v0[3]); w.z = pk2(v1[0], v1[1]); w.w = pk2(v1[2], v1[3]);
                    if (col0 + bj * 128 < ncols) *(u32x4*)(rowp + bj * 128) = w; } }
    }
};
struct EpiF32 {
    static constexpr bool PERM = false, AFTER_DRAIN = false;
    float* C; int ldc;
    __device__ __forceinline__ void operator()(const pg8::f32x4 (&acc)[2][2][4][2], const pg8::Unit& u, int wr, int wc, int fr, int fq) const {
        const int row0 = u.pm * 256 + wr * 64 + fr, col0 = u.pn * 256 + wc * 32 + 4 * fq;
#pragma unroll
        for (int ai = 0; ai < 2; ++ai)
#pragma unroll
            for (int m = 0; m < 4; ++m) { float* rowp = C + (size_t)(row0 + ai * 128 + m * 16) * ldc + col0;
#pragma unroll
                for (int bj = 0; bj < 2; ++bj)
#pragma unroll
                    for (int n = 0; n < 2; ++n) *(pg8::f32x4*)(rowp + bj * 128 + n * 16) = acc[ai][bj][m][n]; }
    }
};
struct EpiPle {
    static constexpr bool PERM = false, AFTER_DRAIN = false;
    float* out; const float* h2; const bf16_t* e; int ldc;
    __device__ __forceinline__ void operator()(const pg8::f32x4 (&acc)[2][2][4][2], const pg8::Unit& u, int wr, int wc, int fr, int fq) const {
        const int row0 = u.pm * 256 + wr * 64 + fr, col0 = u.pn * 256 + wc * 32 + 4 * fq;
#pragma unroll
        for (int ai = 0; ai < 2; ++ai)
#pragma unroll
            for (int m = 0; m < 4; ++m) { const size_t ro = (size_t)(row0 + ai * 128 + m * 16) * ldc + col0;
#pragma unroll
                for (int bj = 0; bj < 2; ++bj)
#pragma unroll
                    for (int n = 0; n < 2; ++n) { const size_t o = ro + bj * 128 + n * 16;
                        const pg8::f32x4 hv = *(const pg8::f32x4*)(h2 + o); const u32x2 ev = *(const u32x2*)(e + o); const pg8::f32x4 a = acc[ai][bj][m][n];
                        pg8::f32x4 r; r[0] = hv[0] + sigm(a[0]) * bflo(ev.x); r[1] = hv[1] + sigm(a[1]) * bfhi(ev.x);
                        r[2] = hv[2] + sigm(a[2]) * bflo(ev.y); r[3] = hv[3] + sigm(a[3]) * bfhi(ev.y);
                        *(pg8::f32x4*)(out + o) = r; } }
    }
};
template <class Epi> __device__ __forceinline__ void run_gemm(unsigned char* smem, const bf16_t* A, const bf16_t* Bt, int M, int N, int K, const Epi& E) {
    pg8::Gemm g{A, Bt, M, N, K}; pg8::StaticOrder S; S.init(M, N, (int)gridDim.x, (int)blockIdx.x);
    pg8::gemm_phase<Epi, pg8::StaticOrder, false>((PG8_LAS unsigned char*)smem, g, S, E, nullptr);
}

constexpr int TSCR = 64 * 65;
__device__ __forceinline__ void transpose_item(const float* __restrict__ W, int K, int N, bf16_t* __restrict__ WT, float* scr, int item, int lane) {
    const int nblk = N / 64, kb = item / nblk, nb = item % nblk, k0 = 64 * kb, n0 = 64 * nb;
    const int lr = lane >> 4, lc = (lane & 15) * 4;
    f32x4 v[16];
#pragma unroll
    for (int i = 0; i < 16; ++i) v[i] = __builtin_nontemporal_load((const f32x4*)(W + (size_t)(k0 + 4 * i + lr) * N + n0 + lc));
#pragma unroll
    for (int i = 0; i < 16; ++i) { float* d = scr + (4 * i + lr) * 65 + lc; d[0] = v[i][0]; d[1] = v[i][1]; d[2] = v[i][2]; d[3] = v[i][3]; }
    asm volatile("s_waitcnt lgkmcnt(0)" ::: "memory");
    const int c = lane & 7;
#pragma unroll
    for (int j = 0; j < 8; ++j) { const int n = (lane >> 3) + 8 * j; const float* s = scr + (8 * c) * 65 + n;
        u32x4 o; o.x = pk2(s[0 * 65], s[1 * 65]); o.y = pk2(s[2 * 65], s[3 * 65]); o.z = pk2(s[4 * 65], s[5 * 65]); o.w = pk2(s[6 * 65], s[7 * 65]);
        *(u32x4*)(WT + (size_t)(n0 + n) * K + k0 + 8 * c) = o; }
    asm volatile("s_waitcnt lgkmcnt(0)" ::: "memory");
}
__device__ __forceinline__ void convert_weights(KP p, int L, int which, unsigned char* smem) {
    const int tid = otid(), lane = tid & 63, wave = tid >> 6;
    float* scr = (float*)smem + wave * TSCR;
    const int gw = blockIdx.x * 8 + wave, NGW = gridDim.x * 8;
    unsigned char* ws = p->ws;
    constexpr int I_IN = 32 * 89, I_OUT = 32 * 32, I_UP = 32 * 128, I_DN = 128 * 32, I_G = 32 * 32, I_P = 4 * 32;
    if (which & 1) { for (int it = gw; it < I_IN; it += NGW) transpose_item(p->in[3] + (size_t)L * D_ * DIN, D_, DIN, (bf16_t*)(ws + WS_WIN), scr, it, lane);
        u32x4* z = (u32x4*)(ws + WS_WIN + (size_t)DIN * D_ * 2); const int nz = (DINP - DIN) * D_ * 2 / 16;
        for (int i = blockIdx.x * NTHR + tid; i < nz; i += gridDim.x * NTHR) z[i] = (u32x4){0u, 0u, 0u, 0u}; }
    if (which & 2) for (int it = gw; it < I_OUT; it += NGW) transpose_item(p->in[16] + (size_t)L * D_ * D_, D_, D_, (bf16_t*)(ws + WS_WOUT), scr, it, lane);
    if (which & 4) for (int it = gw; it < I_UP; it += NGW) transpose_item(p->in[19] + (size_t)L * D_ * DFF, D_, DFF, (bf16_t*)(ws + WS_WUP), scr, it, lane);
    if (which & 8) for (int it = gw; it < I_DN; it += NGW) transpose_item(p->in[20] + (size_t)L * DFF * D_, DFF, D_, (bf16_t*)(ws + WS_WDN), scr, it, lane);
    if (which & 16) { for (int it = gw; it < I_G; it += NGW) transpose_item(p->in[22] + (size_t)L * D_ * D_, D_, D_, (bf16_t*)(ws + WS_WG), scr, it, lane);
        for (int it = gw; it < I_P; it += NGW) transpose_item(p->in[23] + (size_t)L * PLE * D_, PLE, D_, (bf16_t*)(ws + WS_WP), scr, it, lane); }
    __syncthreads();
}

__device__ __forceinline__ void row_phase(const float* __restrict__ h_in, const bf16_t* __restrict__ y, const float* __restrict__ g_post, float* __restrict__ h_out,
                                          const float* __restrict__ g_pre, bf16_t* __restrict__ u_out) {
    const int tid = otid(), lane = tid & 63, wave = tid >> 6;
    for (int row = blockIdx.x * 8 + wave; row < M_; row += gridDim.x * 8) {
        const f32x4* hp = (const f32x4*)(h_in + (size_t)row * D_) + lane;
        f32x4 hv[8];
#pragma unroll
        for (int j = 0; j < 8; ++j) hv[j] = hp[64 * j];
        if (y) {
            const u32x2* yp = (const u32x2*)(y + (size_t)row * D_) + lane; f32x4 yv[8]; float ss = 0.f;
#pragma unroll
            for (int j = 0; j < 8; ++j) { const u32x2 yr = yp[64 * j]; yv[j][0] = bflo(yr.x); yv[j][1] = bfhi(yr.x); yv[j][2] = bflo(yr.y); yv[j][3] = bfhi(yr.y); ss += yv[j][0] * yv[j][0] + yv[j][1] * yv[j][1] + yv[j][2] * yv[j][2] + yv[j][3] * yv[j][3]; }
            const float r = rsqrtf(wave_sum(ss) * (1.f / D_) + EPS);
            f32x4* op = (f32x4*)(h_out + (size_t)row * D_) + lane;
#pragma unroll
            for (int j = 0; j < 8; ++j) { const f32x4 g = ((const f32x4*)g_post)[lane + 64 * j]; hv[j] = hv[j] + yv[j] * r * g; op[64 * j] = hv[j]; }
        }
        float r2 = 1.f;
        if (g_pre) { float ss = 0.f;
#pragma unroll
            for (int j = 0; j < 8; ++j) ss += hv[j][0] * hv[j][0] + hv[j][1] * hv[j][1] + hv[j][2] * hv[j][2] + hv[j][3] * hv[j][3];
            r2 = rsqrtf(wave_sum(ss) * (1.f / D_) + EPS); }
        u32x2* up = (u32x2*)(u_out + (size_t)row * D_) + lane;
#pragma unroll
        for (int j = 0; j < 8; ++j) { f32x4 v = hv[j] * r2; if (g_pre) v = v * ((const f32x4*)g_pre)[lane + 64 * j];
            u32x2 o; o.x = pk2(v[0], v[1]); o.y = pk2(v[2], v[3]); up[64 * j] = o; }
    }
}
__device__ __forceinline__ float dot64(const float (&q)[64], const bf16_t* __restrict__ kp) {
    const u32x4* p4 = (const u32x4*)kp; float s = 0.f;
#pragma unroll
    for (int c = 0; c < 8; ++c) { const u32x4 v = p4[c];
        s += q[8 * c + 0] * bflo(v.x) + q[8 * c + 1] * bfhi(v.x) + q[8 * c + 2] * bflo(v.y) + q[8 * c + 3] * bfhi(v.y)
           + q[8 * c + 4] * bflo(v.z) + q[8 * c + 5] * bfhi(v.z) + q[8 * c + 6] * bflo(v.w) + q[8 * c + 7] * bfhi(v.w); }
    return s;
}
__device__ __forceinline__ void axpy64(float (&o)[64], float sc, float pw, const bf16_t* __restrict__ vp) {
    const u32x4* p4 = (const u32x4*)vp;
#pragma unroll
    for (int c = 0; c < 8; ++c) { const u32x4 v = p4[c];
        o[8 * c + 0] = o[8 * c + 0] * sc + pw * bflo(v.x); o[8 * c + 1] = o[8 * c + 1] * sc + pw * bfhi(v.x);
        o[8 * c + 2] = o[8 * c + 2] * sc + pw * bflo(v.y); o[8 * c + 3] = o[8 * c + 3] * sc + pw * bfhi(v.y);
        o[8 * c + 4] = o[8 * c + 4] * sc + pw * bflo(v.z); o[8 * c + 5] = o[8 * c + 5] * sc + pw * bfhi(v.z);
        o[8 * c + 6] = o[8 * c + 6] * sc + pw * bflo(v.w); o[8 * c + 7] = o[8 * c + 7] * sc + pw * bfhi(v.w); }
}

__device__ __forceinline__ void compress_item(KP p, int L, int w, int lane) {
    const int kv = w / 2040, r1 = w % 2040, b = r1 / 1020, r2 = r1 % 1020, n = r2 >> 2, g = r2 & 3;
    const float* W = p->in[4] + ((size_t)L * 2 + kv) * 2048 * 64;
    const float* pe = p->in[5] + ((size_t)L * 2 + kv) * 2048;
    const bf16_t* src = (const bf16_t*)(p->ws + WS_PROJ) + ((size_t)(b * T_ + 16 * n)) * DIN + C_KV + kv * 256 + g * 64;
    float acc = 0.f;
    for (int l = 0; l < 32; ++l) { const bf16_t* row = src + (size_t)l * DIN;
#pragma unroll 8
        for (int dd = 0; dd < 64; ++dd) { const float a = bf2f(row[dd]) + pe[l * 64 + dd]; acc += a * W[(size_t)(l * 64 + dd) * 64 + lane]; } }
    bf16_t* dst = (bf16_t*)(p->ws + (kv ? WS_VC : WS_KC));
    dst[((size_t)(b * NCMP + n) * 4 + g) * 64 + lane] = f2bf(acc);
}

__device__ __forceinline__ void nsa_naive_item(KP p, int item, unsigned char* smem) {
    const int tid = otid(), lane = tid & 63;
    const int b = item >> 7, t = (item & 127) * 32 + (tid >> 4), hq = tid & 15, g = hq >> 2, hh = hq & 3;
    const bf16_t* proj = (const bf16_t*)(p->ws + WS_PROJ);
    const bf16_t* prow = proj + (size_t)(b * T_ + t) * DIN;
    const bf16_t* kc = (const bf16_t*)(p->ws + WS_KC); const bf16_t* vc = (const bf16_t*)(p->ws + WS_VC);
    float* impp = (float*)smem + (tid >> 2) * 64;
    float q[64];
    { const u32x4* qp = (const u32x4*)(prow + C_Q + hq * 64);
#pragma unroll
      for (int c = 0; c < 8; ++c) { const u32x4 v = qp[c]; q[8*c+0] = 0.125f * bflo(v.x); q[8*c+1] = 0.125f * bfhi(v.x); q[8*c+2] = 0.125f * bflo(v.y); q[8*c+3] = 0.125f * bfhi(v.y);
          q[8*c+4] = 0.125f * bflo(v.z); q[8*c+5] = 0.125f * bfhi(v.z); q[8*c+6] = 0.125f * bflo(v.w); q[8*c+7] = 0.125f * bfhi(v.w); } }
    const float slope = exp2f(-0.5f * (float)(hq + 1));
    const float g0 = sigm(bf2f(prow[C_G + hq * 3 + 0])), g1 = sigm(bf2f(prow[C_G + hq * 3 + 1])), g2 = sigm(bf2f(prow[C_G + hq * 3 + 2]));
    float outv[64];
#pragma unroll
    for (int d = 0; d < 64; ++d) outv[d] = 0.f;
    if (hh == 0) { for (int j = 0; j < 64; ++j) impp[j] = 0.f; }
    const int nvalid = (t >= 31) ? ((t - 31) / 16 + 1) : 0;
    {
        float m = -1e30f, l = 0.f;
        for (int n = 0; n < nvalid; ++n) { const float s = dot64(q, kc + ((size_t)(b * NCMP + n) * 4 + g) * 64) - slope * (float)(t - (16 * n + 31));
            const float mn = fmaxf(m, s); l = l * expf(m - mn) + expf(s - mn); m = mn; }
        const float il = (l > 0.f) ? 1.f / l : 0.f;
        for (int n = 0; n < nvalid; ++n) { const size_t ko = ((size_t)(b * NCMP + n) * 4 + g) * 64;
            const float s = dot64(q, kc + ko) - slope * (float)(t - (16 * n + 31));
            const float pw = expf(s - m) * il;
            axpy64(outv, 1.f, pw * g0, vc + ko);
            float ps = pw; ps += __shfl_xor(ps, 1); ps += __shfl_xor(ps, 2);
            if (hh == 0) { impp[n >> 2] += ps; if ((n & 3) == 3 && (n >> 2) < 63) impp[(n >> 2) + 1] += ps; } }
    }
    const int tb = t >> 6;
    unsigned mlo = 0u, mhi = 0u;
    if (hh == 0) {
        unsigned long long mask;
        if (tb < 16) mask = (1ull << (tb + 1)) - 1ull;
        else { mask = 1ull | (1ull << tb) | (1ull << (tb - 1));
            for (int r = 0; r < 13; ++r) { int best = 1; float bv = -1.f;
                for (int j = 1; j <= tb - 2; ++j) { const float v = impp[j]; if (!((mask >> j) & 1ull) && v > bv) { bv = v; best = j; } }
                mask |= 1ull << best; } }
        mlo = (unsigned)mask; mhi = (unsigned)(mask >> 32);
    }
    mlo = __shfl(mlo, lane & ~3); mhi = __shfl(mhi, lane & ~3);
    const unsigned long long mask = ((unsigned long long)mhi << 32) | mlo;
    {
        float m = -1e30f, l = 0.f;
        const bf16_t* kb = proj + (size_t)(b * T_) * DIN + C_KV + 2 * 256 + g * 64; const bf16_t* vb = kb + 256;
        for (int j = 0; j <= tb; ++j) { if (!((mask >> j) & 1ull)) continue;
            const int pend = min(t, 64 * j + 63);
            for (int pos = 64 * j; pos <= pend; ++pos) { const float s = dot64(q, kb + (size_t)pos * DIN) - slope * (float)(t - pos);
                const float mn = fmaxf(m, s); l = l * expf(m - mn) + expf(s - mn); m = mn; } }
        const float f = g1 / l;
        for (int j = 0; j <= tb; ++j) { if (!((mask >> j) & 1ull)) continue;
            const int pend = min(t, 64 * j + 63);
            for (int pos = 64 * j; pos <= pend; ++pos) { const float s = dot64(q, kb + (size_t)pos * DIN) - slope * (float)(t - pos);
                axpy64(outv, 1.f, f * expf(s - m), vb + (size_t)pos * DIN); } }
    }
    {
        float m = -1e30f, l = 0.f;
        const bf16_t* kb = proj + (size_t)(b * T_) * DIN + C_KV + 4 * 256 + g * 64; const bf16_t* vb = kb + 256;
        const int p0 = max(0, t - 511);
        for (int pos = p0; pos <= t; ++pos) { const float s = dot64(q, kb + (size_t)pos * DIN) - slope * (float)(t - pos);
            const float mn = fmaxf(m, s); l = l * expf(m - mn) + expf(s - mn); m = mn; }
        const float f = g2 / l;
        for (int pos = p0; pos <= t; ++pos) { const float s = dot64(q, kb + (size_t)pos * DIN) - slope * (float)(t - pos);
            axpy64(outv, 1.f, f * expf(s - m), vb + (size_t)pos * DIN); }
    }
    u32x4* op = (u32x4*)((bf16_t*)(p->ws + WS_MIX) + (size_t)(b * T_ + t) * D_ + hq * 64);
#pragma unroll
    for (int c = 0; c < 8; ++c) { u32x4 w; w.x = pk2(outv[8*c], outv[8*c+1]); w.y = pk2(outv[8*c+2], outv[8*c+3]); w.z = pk2(outv[8*c+4], outv[8*c+5]); w.w = pk2(outv[8*c+6], outv[8*c+7]); op[c] = w; }
}

__device__ __forceinline__ void lru_prep_item(KP p, int L, int item, unsigned char* smem) {
    const int c = otid(), b = item >> 6, n = item & 63;
    float* xs = (float*)smem;
    const bf16_t* proj = (const bf16_t*)(p->ws + WS_PROJ);
    const float lam = p->in[12][L * 512 + c]; const float sp = log1pf(expf(-lam));
    float cw[4];
#pragma unroll
    for (int k = 0; k < 4; ++k) cw[k] = p->in[6][(L * 4 + k) * 512 + c];
    const float cb = p->in[7][L * 512 + c], ba = p->in[9][L * 512 + c], bi = p->in[11][L * 512 + c];
    const int blk = c >> 6, d = c & 63;
    const float* wa = p->in[8] + (size_t)L * 8 * 4096 + blk * 4096 + d; const float* wi = p->in[10] + (size_t)L * 8 * 4096 + blk * 4096 + d;
    float* hl = (float*)(p->ws + WS_LH); float* pp = (float*)(p->ws + WS_LP);
    float h = 0.f, P = 1.f;
    const int t0 = n * 64;
    float x0 = (t0 >= 3) ? bf2f(proj[(size_t)(b * T_ + t0 - 3) * DIN + C_LX + c]) : 0.f;
    float x1 = (t0 >= 2) ? bf2f(proj[(size_t)(b * T_ + t0 - 2) * DIN + C_LX + c]) : 0.f;
    float x2 = (t0 >= 1) ? bf2f(proj[(size_t)(b * T_ + t0 - 1) * DIN + C_LX + c]) : 0.f;
    for (int tt = 0; tt < 64; ++tt) { const int t = t0 + tt;
        const float x3 = bf2f(proj[(size_t)(b * T_ + t) * DIN + C_LX + c]);
        const float xc = cb + cw[0] * x0 + cw[1] * x1 + cw[2] * x2 + cw[3] * x3;
        x0 = x1; x1 = x2; x2 = x3;
        float* xb = xs + (tt & 1) * 512; xb[c] = xc;
        __syncthreads();
        float ra = ba, ri = bi;
#pragma unroll 8
        for (int k = 0; k < 64; ++k) { const float xv = xb[blk * 64 + k]; ra += xv * wa[k * 64]; ri += xv * wi[k * 64]; }
        const float r = sigm(ra), ig = sigm(ri);
        const float log_a = -8.f * r * sp; const float a = expf(log_a);
        const float u = sqrtf(-expm1f(2.f * log_a)) * (ig * xc);
        h = a * h + u; P *= a;
        hl[(size_t)(b * T_ + t) * 512 + c] = h; pp[(size_t)(b * T_ + t) * 512 + c] = P;
    }
    __syncthreads();
}
__device__ __forceinline__ float gelu_tanh(float x) { const float u = 0.7978845608028654f * (x + 0.044715f * x * x * x); const float th = 1.f - 2.f * __builtin_amdgcn_rcpf(1.f + fexp(2.f * u)); return 0.5f * x * (1.f + th); }
__device__ __forceinline__ void lru_out_item(KP p, int item) {
    const int c = otid(), b = item >> 7, n = (item >> 1) & 63, hc = item & 1;
    const float* hl = (const float*)(p->ws + WS_LH); const float* pp = (const float*)(p->ws + WS_LP);
    const bf16_t* proj = (const bf16_t*)(p->ws + WS_PROJ); bf16_t* mix = (bf16_t*)(p->ws + WS_MIX);
    float carry = 0.f;
#pragma unroll 16
    for (int m = 0; m < n; ++m) { const size_t o = (size_t)(b * T_ + m * 64 + 63) * 512 + c; carry = pp[o] * carry + hl[o]; }
#pragma unroll 16
    for (int tt = 0; tt < 32; ++tt) { const size_t row = (size_t)(b * T_ + n * 64 + hc * 32 + tt);
        const float h = hl[row * 512 + c] + pp[row * 512 + c] * carry;
        const float y = bf2f(proj[row * DIN + C_LY + c]);
        mix[row * D_ + 1024 + c] = f2bf(h * gelu_tanh(y)); }
}

constexpr int GP = 130;
__device__ __forceinline__ void gla_prep_item(KP p, int L, int item, unsigned char* smem) {
    const int tid = otid(), b = item >> 8, n = (item >> 2) & 63, h = item & 3;
    float* Bc = (float*)smem;
    bf16_t* Qt = (bf16_t*)(smem + 32768);
    bf16_t* Kt = Qt + 64 * GP; bf16_t* Ke = Kt + 64 * GP; bf16_t* Vs = Ke + 64 * GP;
    float* Att = (float*)(smem + 99328);
    float* zs = (float*)(smem + 115968);
    float* segt = (float*)(smem + 120064);
    const bf16_t* proj = (const bf16_t*)(p->ws + WS_PROJ);
    const size_t row0 = (size_t)(b * T_ + n * 64);
    for (int i = tid; i < 1024; i += NTHR) { const int t = i >> 4, r = i & 15; zs[i] = bf2f(proj[(row0 + t) * DIN + C_GZ + r]); }
    __syncthreads();
    { const int c = tid & 127, seg = tid >> 7; float w2c[16];
#pragma unroll
      for (int r = 0; r < 16; ++r) w2c[r] = p->in[13][((size_t)L * 16 + r) * 512 + h * 128 + c];
      const float bg = p->in[14][L * 512 + h * 128 + c]; float run = 0.f;
      for (int i = 0; i < 16; ++i) { const int t = seg * 16 + i; float x = bg;
#pragma unroll
          for (int r = 0; r < 16; ++r) x += zs[t * 16 + r] * w2c[r];
          const float ls = fminf(x, 0.f) - log1pf(expf(-fabsf(x)));
          run += ls * (1.f / 16.f); Bc[t * 128 + c] = run; }
      segt[seg * 128 + c] = run; }
    __syncthreads();
    { const int c = tid & 127, seg = tid >> 7; float off = 0.f; for (int s = 0; s < seg; ++s) off += segt[s * 128 + c];
      if (seg > 0) for (int i = 0; i < 16; ++i) Bc[(seg * 16 + i) * 128 + c] += off; }
    __syncthreads();
    bf16_t* gqt = (bf16_t*)(p->ws + WS_GQT); float* gdec = (float*)(p->ws + WS_GDEC);
    for (int i = tid; i < 8192; i += NTHR) { const int t = i >> 7, c = i & 127; const bf16_t* pr = proj + (row0 + t) * DIN + h * 128 + c;
        const float bc = Bc[t * 128 + c], bl = Bc[63 * 128 + c];
        const float qv = bf2f(pr[C_GQ]) * 0.08838834764831845f * expf(bc), kv = bf2f(pr[C_GK]);
        const bf16_t qb = f2bf(qv);
        Qt[t * GP + c] = qb; Kt[t * GP + c] = f2bf(kv * expf(-bc)); Ke[t * GP + c] = f2bf(kv * expf(bl - bc)); Vs[t * GP + c] = pr[C_GV];
        gqt[(row0 + t) * 512 + h * 128 + c] = qb;
        if (t == 63) gdec[(size_t)((b * 64 + n) * 4 + h) * 128 + c] = expf(bl); }
    __syncthreads();
    { const int t = tid >> 3, sg = tid & 7; const unsigned* qr = (const unsigned*)(Qt + t * GP);
      for (int i = 0; i < 8; ++i) { const int s = sg * 8 + i; float a = 0.f;
          if (s <= t) { const unsigned* kr = (const unsigned*)(Kt + s * GP);
#pragma unroll 8
              for (int k = 0; k < 64; ++k) { const unsigned qa = qr[k], ka = kr[k]; a += bflo(qa) * bflo(ka) + bfhi(qa) * bfhi(ka); } }
          Att[t * 65 + s] = a; } }
    __syncthreads();
    { const int v = tid & 127, tg = tid >> 7; float* goi = (float*)(p->ws + WS_GOI);
      for (int i = 0; i < 16; ++i) { const int t = tg * 16 + i; float a = 0.f;
          for (int s = 0; s <= t; ++s) a += Att[t * 65 + s] * bf2f(Vs[s * GP + v]);
          goi[(row0 + t) * 512 + h * 128 + v] = a; } }
    { const int k = tid & 127, vg = tid >> 7; float acc[32];
#pragma unroll
      for (int i = 0; i < 32; ++i) acc[i] = 0.f;
      for (int s = 0; s < 64; ++s) { const float ke = bf2f(Ke[s * GP + k]); const unsigned* vr = (const unsigned*)(Vs + s * GP + vg * 32);
#pragma unroll
          for (int i = 0; i < 16; ++i) { const unsigned vv = vr[i]; acc[2 * i] += bflo(vv) * ke; acc[2 * i + 1] += bfhi(vv) * ke; } }
      float* gupd = (float*)(p->ws + WS_GUPD) + (size_t)((b * 64 + n) * 4 + h) * 16384;
#pragma unroll
      for (int i = 0; i < 32; ++i) gupd[(vg * 32 + i) * 128 + k] = acc[i]; }
    __syncthreads();
}
__device__ __forceinline__ void gla_scan(KP p) {
    float* gupd = (float*)(p->ws + WS_GUPD); const float* gdec = (const float*)(p->ws + WS_GDEC);
    const int tid = otid();
    for (int e = blockIdx.x * NTHR + tid; e < 131072; e += gridDim.x * NTHR) {
        const int b = e >> 16, h = (e >> 14) & 3, vk = e & 16383, k = e & 127; float S = 0.f;
#pragma unroll 1
        for (int n0 = 0; n0 < 64; n0 += 32) { float u[32], d[32];
#pragma unroll
            for (int i = 0; i < 32; ++i) { const size_t bi = (size_t)((b * 64 + n0 + i) * 4 + h); u[i] = gupd[bi * 16384 + vk]; d[i] = gdec[bi * 128 + k]; }
#pragma unroll
            for (int i = 0; i < 32; ++i) { const size_t bi = (size_t)((b * 64 + n0 + i) * 4 + h); gupd[bi * 16384 + vk] = S; S = d[i] * S + u[i]; } }
    }
}
__device__ __forceinline__ void gla_out_item(KP p, int L, int item, unsigned char* smem) {
    const int tid = otid(), lane = tid & 63, wave = tid >> 6, b = item >> 8, n = (item >> 2) & 63, h = item & 3;
    float* ST = (float*)smem;
    float* Qs = (float*)(smem + 66048);
    const float* gupd = (const float*)(p->ws + WS_GUPD) + (size_t)((b * 64 + n) * 4 + h) * 16384;
    const bf16_t* gqt = (const bf16_t*)(p->ws + WS_GQT); const float* goi = (const float*)(p->ws + WS_GOI);
    const bf16_t* proj = (const bf16_t*)(p->ws + WS_PROJ); bf16_t* mix = (bf16_t*)(p->ws + WS_MIX);
    const size_t row0 = (size_t)(b * T_ + n * 64);
    for (int i = tid; i < 16384; i += NTHR) ST[(i >> 7) * 129 + (i & 127)] = gupd[i];
    for (int i = tid; i < 8192; i += NTHR) Qs[i] = bf2f(gqt[(row0 + (i >> 7)) * 512 + h * 128 + (i & 127)]);
    __syncthreads();
    const float gn0 = p->in[15][L * 512 + h * 128 + lane], gn1 = p->in[15][L * 512 + h * 128 + lane + 64];
    for (int ti = 0; ti < 8; ++ti) { const int t = wave * 8 + ti; const float* qr = Qs + t * 128; const float* s0 = ST + lane * 129; const float* s1 = ST + (lane + 64) * 129;
        float o0 = 0.f, o1 = 0.f;
#pragma unroll 8
        for (int k = 0; k < 128; ++k) { const float qv = qr[k]; o0 += qv * s0[k]; o1 += qv * s1[k]; }
        o0 += goi[(row0 + t) * 512 + h * 128 + lane]; o1 += goi[(row0 + t) * 512 + h * 128 + lane + 64];
        const float r = rsqrtf(wave_sum(o0 * o0 + o1 * o1) * (1.f / 128.f) + EPS);
        const float r0 = bf2f(proj[(row0 + t) * DIN + C_GR + h * 128 + lane]), r1 = bf2f(proj[(row0 + t) * DIN + C_GR + h * 128 + lane + 64]);
        mix[(row0 + t) * D_ + 1536 + h * 128 + lane] = f2bf(o0 * r * gn0 * (r0 * sigm(r0)));
        mix[(row0 + t) * D_ + 1536 + h * 128 + lane + 64] = f2bf(o1 * r * gn1 * (r1 * sigm(r1))); }
    __syncthreads();
}
typedef short bf16x8 __attribute__((ext_vector_type(8)));
typedef float f32x16 __attribute__((ext_vector_type(16)));
__device__ __forceinline__ unsigned cvtpk(float lo, float hi) { return pk2(lo, hi); }
__device__ __forceinline__ float fexp2(float x) { return __builtin_amdgcn_exp2f(x); }
constexpr int NS_KP = 144, NS_VP = 136;
constexpr int NS_BUF = 64 * NS_KP + 64 * NS_VP;
constexpr int NS_OWN = 36864, NS_SPL = NS_OWN + 64 * 64 * 4, NS_MSK = NS_SPL + 64 * 65 * 4, NS_OUTB = 73728;

__device__ __forceinline__ void ns_pv(const unsigned char* vbuf, const bf16x8 (&pb)[2][2], int c, int hf, f32x16 (&ot)[2]) {
#pragma unroll
    for (int kh = 0; kh < 2; ++kh)
#pragma unroll
        for (int s2 = 0; s2 < 2; ++s2)
#pragma unroll
            for (int dh = 0; dh < 2; ++dh) { const unsigned char* rp = vbuf + (dh * 32 + c) * NS_VP + (kh * 32 + 16 * s2 + 4 * hf) * 2;
                const u32x2 lo = *(const u32x2*)rp, hi = *(const u32x2*)(rp + 16);
                u32x4 av; av.x = lo.x; av.y = lo.y; av.z = hi.x; av.w = hi.y;
                ot[dh] = __builtin_amdgcn_mfma_f32_32x32x16_bf16(__builtin_bit_cast(bf16x8, av), pb[kh][s2], ot[dh], 0, 0, 0); }
}
__device__ __forceinline__ void ns_pack(const f32x16 (&st)[2], bf16x8 (&pb)[2][2]) {
#pragma unroll
    for (int kh = 0; kh < 2; ++kh)
#pragma unroll
        for (int s2 = 0; s2 < 2; ++s2) { u32x4 w; w.x = cvtpk(st[kh][8 * s2 + 0], st[kh][8 * s2 + 1]); w.y = cvtpk(st[kh][8 * s2 + 2], st[kh][8 * s2 + 3]);
            w.z = cvtpk(st[kh][8 * s2 + 4], st[kh][8 * s2 + 5]); w.w = cvtpk(st[kh][8 * s2 + 6], st[kh][8 * s2 + 7]); pb[kh][s2] = __builtin_bit_cast(bf16x8, w); }
}
__device__ __forceinline__ void ns_store_tile(unsigned char* buf, int tid, const u32x4& kr, const u32x4& vr) {
    const int row = tid >> 3, ch = tid & 7;
    *(u32x4*)(buf + row * NS_KP + ch * 16) = kr;
    *(u32x2*)(buf + 64 * NS_KP + row * NS_VP + ch * 16) = (u32x2){vr.x, vr.y}; *(u32x2*)(buf + 64 * NS_KP + row * NS_VP + ch * 16 + 8) = (u32x2){vr.z, vr.w};
}
typedef unsigned u32x2s __attribute__((ext_vector_type(2)));
__device__ __forceinline__ float dpp_xor1(float x) { return __builtin_bit_cast(float, __builtin_amdgcn_mov_dpp(__builtin_bit_cast(int, x), 0xB1, 0xF, 0xF, true)); }
__device__ __forceinline__ float dpp_xor2(float x) { return __builtin_bit_cast(float, __builtin_amdgcn_mov_dpp(__builtin_bit_cast(int, x), 0x4E, 0xF, 0xF, true)); }
__device__ __forceinline__ float half_max(float x) { const u32x2s r = __builtin_amdgcn_permlane32_swap(__builtin_bit_cast(unsigned, x), __builtin_bit_cast(unsigned, x), false, false); return fmaxf(__builtin_bit_cast(float, r.x), __builtin_bit_cast(float, r.y)); }
__device__ __forceinline__ float half_sum(float x) { const u32x2s r = __builtin_amdgcn_permlane32_swap(__builtin_bit_cast(unsigned, x), __builtin_bit_cast(unsigned, x), false, false); return __builtin_bit_cast(float, r.x) + __builtin_bit_cast(float, r.y); }
__device__ __forceinline__ float lane_read(float x, int i) { return __builtin_bit_cast(float, __builtin_amdgcn_readlane(__builtin_bit_cast(int, x), i)); }
__device__ __forceinline__ float vsubf(float a, float b) { return a - b; }
__device__ __forceinline__ float vaddf(float a, float b) { return a + b; }
__device__ __forceinline__ float vmulf(float a, float b) { return a * b; }
__device__ __forceinline__ void ns_qk(const unsigned char* kbuf, const bf16x8 (&qf)[4], const bf16x8& qx, const bf16x8 (&kx)[2], int c, int hf, f32x16 (&st)[2], float cinit) {
#pragma unroll
    for (int kh = 0; kh < 2; ++kh) {
#pragma unroll
        for (int i = 0; i < 16; ++i) st[kh][i] = cinit;
        st[kh] = __builtin_amdgcn_mfma_f32_32x32x16_bf16(kx[kh], qx, st[kh], 0, 0, 0); }
#pragma unroll
    for (int s = 0; s < 4; ++s)
#pragma unroll
        for (int kh = 0; kh < 2; ++kh) { const bf16x8 a = *(const bf16x8*)(kbuf + (kh * 32 + c) * NS_KP + (16 * s + 8 * hf) * 2);
            st[kh] = __builtin_amdgcn_mfma_f32_32x32x16_bf16(a, qf[s], st[kh], 0, 0, 0); }
}
template <int KM, bool LOWER, bool UPPER> __device__ __forceinline__ void ns_mask(f32x16 (&st)[2], float d0f) {
    asm volatile("" ::: "memory");
    const float d0u = d0f - 511.f;
#pragma unroll
    for (int kh = 0; kh < 2; ++kh)
#pragma unroll
        for (int i = 0; i < 16; ++i) { const float kc = (float)(KM * (kh * 32 + (i & 3) + 8 * (i >> 2)));
            bool ok = true; if (LOWER) ok = ok && (kc <= d0f); if (UPPER) ok = ok && (kc >= d0u);
            st[kh][i] = ok ? st[kh][i] : -INFINITY; }
}
__device__ __forceinline__ float ns_tilemax(const f32x16 (&st)[2]) {
    float mx = st[0][0];
#pragma unroll
    for (int kh = 0; kh < 2; ++kh)
#pragma unroll
        for (int i = 0; i < 16; ++i) mx = fmaxf(mx, st[kh][i]);
    return fmaxf(mx, __shfl_xor(mx, 32));
}
__device__ __forceinline__ float ns_exp(f32x16 (&st)[2], float mref) {
    float ps[4] = {0.f, 0.f, 0.f, 0.f};
#pragma unroll
    for (int kh = 0; kh < 2; ++kh)
#pragma unroll
        for (int i = 0; i < 16; ++i) { const float pw = fexp2(vsubf(st[kh][i], mref)); st[kh][i] = pw; ps[i & 3] = vaddf(ps[i & 3], pw); }
    return vaddf(vaddf(ps[0], ps[1]), vaddf(ps[2], ps[3]));
}
template <bool PV> __device__ __forceinline__ void ns_softmax(f32x16 (&st)[2], float base, bool lanevalid, float& m, float& l, f32x16 (&ot)[2], const unsigned char* vbuf, int c, int hf) {
    const float mxp = ns_tilemax(st); const float mx = lanevalid ? mxp + base : -INFINITY;
    const float mn = (mx > m + 8.f) ? mx : m; const float alpha = fexp2(m - mn); m = mn;
    const float ps = ns_exp(st, lanevalid ? mn - base : INFINITY);
    l = l * alpha + ps;
    if (PV) {
        if (__builtin_amdgcn_ballot_w64(alpha != 1.f) != 0ull) {
#pragma unroll
            for (int dh = 0; dh < 2; ++dh)
#pragma unroll
                for (int i = 0; i < 16; ++i) ot[dh][i] = vmulf(ot[dh][i], alpha); }
        bf16x8 pb[2][2]; ns_pack(st, pb); ns_pv(vbuf, pb, c, hf, ot);
    }
}
__device__ __forceinline__ void ns_softmax_rel(f32x16 (&st)[2], float& m, float& l, f32x16 (&ot)[2], const unsigned char* vbuf, int c, int hf) {
    float mxh = st[0][0];
#pragma unroll
    for (int kh = 0; kh < 2; ++kh)
#pragma unroll
        for (int i = 0; i < 16; ++i) mxh = fmaxf(mxh, st[kh][i]);
    if (__builtin_amdgcn_ballot_w64(mxh > 8.f) != 0ull) {
        const float mxp = fmaxf(mxh, __shfl_xor(mxh, 32));
        const float delta = (mxp > 8.f) ? mxp : 0.f; const float alpha = fexp2(-delta); m += delta; l *= alpha;
#pragma unroll
        for (int kh = 0; kh < 2; ++kh)
#pragma unroll
            for (int i = 0; i < 16; ++i) st[kh][i] -= delta;
#pragma unroll
        for (int dh = 0; dh < 2; ++dh)
#pragma unroll
            for (int i = 0; i < 16; ++i) ot[dh][i] *= alpha;
    }
    float ps[4] = {0.f, 0.f, 0.f, 0.f};
#pragma unroll
    for (int kh = 0; kh < 2; ++kh)
#pragma unroll
        for (int i = 0; i < 16; ++i) { const float pw = fexp2(st[kh][i]); st[kh][i] = pw; ps[i & 3] += pw; }
    l += (ps[0] + ps[1]) + (ps[2] + ps[3]);
    bf16x8 pb[2][2]; ns_pack(st, pb); ns_pv(vbuf, pb, c, hf, ot);
}

__device__ __forceinline__ void ns_cmp2_tail(f32x16 (&st)[2], f32x16 (&ot)[2], const unsigned char* buf, int ti, int c, int hf, int hh, int wave, int tokl, float* OWN, float* SPL) {
#pragma unroll
    for (int kh = 0; kh < 2; ++kh)
#pragma unroll
        for (int i = 0; i < 16; ++i) st[kh][i] = fexp2(st[kh][i]);
#pragma unroll
    for (int kh = 0; kh < 2; ++kh)
#pragma unroll
        for (int q4 = 0; q4 < 4; ++q4) { float qs = (st[kh][4 * q4] + st[kh][4 * q4 + 1]) + (st[kh][4 * q4 + 2] + st[kh][4 * q4 + 3]); float pl = st[kh][4 * q4 + 3];
            qs += dpp_xor1(qs); qs += dpp_xor2(qs); pl += dpp_xor1(pl); pl += dpp_xor2(pl);
            const int j = 16 * ti + 8 * kh + 2 * q4 + hf;
            if (hh == 0 && j < 64) { OWN[(8 * wave + tokl) * 64 + j] = qs; SPL[(8 * wave + tokl) * 65 + j + 1] = pl; } }
    bf16x8 pb[2][2]; ns_pack(st, pb); ns_pv(buf + 64 * NS_KP, pb, c, hf, ot);
}
__device__ __forceinline__ void nsa_item(KP p, int item, unsigned char* smem) {
    const int tid = otid(), lane = tid & 63, wave = tid >> 6, c = lane & 31, hf = lane >> 5, tokl = c >> 2, hh = c & 3;
    const int rnd = item >> 8, r8 = item & 255, b = r8 & 1, g0_ = (r8 >> 1) & 3, g = rnd == 0 ? g0_ : 3 - g0_, tbh = r8 >> 3, tb = rnd == 0 ? 63 - tbh : tbh;
    const int t = 64 * tb + 8 * wave + tokl, hq = g * 4 + hh;
    const bf16_t* proj = (const bf16_t*)(p->ws + WS_PROJ);
    const bf16_t* prow = proj + (size_t)(b * T_ + t) * DIN;
    const bf16_t* kc = (const bf16_t*)(p->ws + WS_KC); const bf16_t* vct = (const bf16_t*)(p->ws + WS_VCT);
    const float LOG2E = 1.4426950408889634f;
    const float slope2 = exp2f(-0.5f * (float)(hq + 1)) * LOG2E, scl = 0.125f * LOG2E;
    bf16x8 qf[4];
#pragma unroll
    for (int s = 0; s < 4; ++s) { const u32x4 qr = *(const u32x4*)(prow + C_Q + hq * 64 + 16 * s + 8 * hf); u32x4 w;
        w.x = cvtpk(bflo(qr.x) * scl, bfhi(qr.x) * scl); w.y = cvtpk(bflo(qr.y) * scl, bfhi(qr.y) * scl); w.z = cvtpk(bflo(qr.z) * scl, bfhi(qr.z) * scl); w.w = cvtpk(bflo(qr.w) * scl, bfhi(qr.w) * scl);
        qf[s] = __builtin_bit_cast(bf16x8, w); }
    bf16x8 qx, kx[2], kx16[2];
    { const unsigned shi = f2bf(slope2); const unsigned slo = f2bf(slope2 - bf2f((bf16_t)shi)); u32x4 w = {0u, 0u, 0u, 0u}; if (hf == 0) w.x = shi | (slo << 16); qx = __builtin_bit_cast(bf16x8, w);
#pragma unroll
      for (int kh = 0; kh < 2; ++kh) { const unsigned k1 = f2bf((float)(kh * 32 + c)), k16 = f2bf((float)(16 * (kh * 32 + c))); u32x4 a = {0u, 0u, 0u, 0u}, b16 = {0u, 0u, 0u, 0u};
          if (hf == 0) { a.x = k1 | (k1 << 16); b16.x = k16 | (k16 << 16); } kx[kh] = __builtin_bit_cast(bf16x8, a); kx16[kh] = __builtin_bit_cast(bf16x8, b16); } }
    const float g0 = sigm(bf2f(prow[C_G + hq * 3 + 0])), g1 = sigm(bf2f(prow[C_G + hq * 3 + 1])), g2 = sigm(bf2f(prow[C_G + hq * 3 + 2]));
    float* OWN = (float*)(smem + NS_OWN); float* SPL = (float*)(smem + NS_SPL); unsigned* MSK = (unsigned*)(smem + NS_MSK);
    for (int i = tid; i < 64 * 64 + 64 * 65; i += NTHR) OWN[i] = 0.f;
    float* OUTB = (float*)(smem + NS_OUTB) + tid;
    f32x16 ot[2], st[2];
#pragma unroll
    for (int dh = 0; dh < 2; ++dh)
#pragma unroll
        for (int i = 0; i < 16; ++i) ot[dh][i] = 0.f;
    const int lkey = tid >> 3, lch = tid & 7;
    const bf16_t* vst = (const bf16_t*)(p->ws + WS_VST) + ((size_t)((b * 4 + g) * 64 + lkey)) * T_ + lch * 8;
    const bf16_t* vwt = (const bf16_t*)(p->ws + WS_VWT) + ((size_t)((b * 4 + g) * 64 + lkey)) * T_ + lch * 8;
#define NS_PIPE(NT, LOADNEXT, COMPUTE) do { const int _n = (NT); u32x4 k0r, v0r, k1r, v1r; \
        LOADNEXT(k0r, v0r); LOADNEXT(k1r, v1r); \
        ns_store_tile(smem, tid, k0r, v0r); LOADNEXT(k0r, v0r); \
        __syncthreads(); \
        for (int _k = 0; _k < _n; _k += 2) {     \
            COMPUTE(smem); \
            ns_store_tile(smem + NS_BUF, tid, k1r, v1r); LOADNEXT(k1r, v1r); \
            __syncthreads(); \
            if (_k + 1 < _n) { COMPUTE((smem + NS_BUF)); } \
            ns_store_tile(smem, tid, k0r, v0r); LOADNEXT(k0r, v0r); \
            __syncthreads(); } } while (0)
    const int ncmp_t = (4 * tb + 3 + 63) >> 6;
    float m = -1e30f, l = 0.f;
    const float d0c = (float)(t - 31 - 64 * hf);
#define NS_CMP_ADDR(ti) ((((size_t)(b * NCMP + min(64 * (ti) + lkey, NCMP - 1))) * 4 + g) * 64 + lch * 8)
    int lti = 0, cti = 0;
#define NS_CMP_LOAD(KR, VR) { const int lt_ = min(lti, ncmp_t - 1); KR = *(const u32x4*)(kc + NS_CMP_ADDR(lt_)); VR = *(const u32x4*)(vct + ((size_t)((b * 4 + g) * 64 + lkey)) * 256 + 64 * lt_ + lch * 8); ++lti; }
#define NS_CMP1_BODY(BUF) { const int ti = cti++; unsigned char* buf = (BUF); \
        ns_qk(buf, qf, qx, kx16, c, hf, st, 0.f); \
        const float d0f = d0c - 1024.f * (float)ti; \
        if (!(16 * (64 * ti + 63) + 31 <= 64 * tb + 8 * wave)) ns_mask<16, true, false>(st, d0f); \
        ns_softmax<false>(st, slope2 * (1024.f * (float)ti - (float)(t - 31)), true, m, l, ot, buf, c, hf); }
    NS_PIPE(ncmp_t, NS_CMP_LOAD, NS_CMP1_BODY);
    l += __shfl_xor(l, 32);
    const float mrefc = (l > 0.f) ? m + __log2f(l) : INFINITY;
    lti = 0; cti = 0;
#define NS_CMP2_BODY(BUF) { const int ti = cti++; unsigned char* buf = (BUF); \
        ns_qk(buf, qf, qx, kx16, c, hf, st, slope2 * (1024.f * (float)ti - (float)(t - 31)) - mrefc);     \
        const float d0f = d0c - 1024.f * (float)ti; \
        if (!(16 * (64 * ti + 63) + 31 <= 64 * tb + 8 * wave)) ns_mask<16, true, false>(st, d0f); \
        ns_cmp2_tail(st, ot, buf, ti, c, hf, hh, wave, tokl, OWN, SPL); }
    NS_PIPE(ncmp_t, NS_CMP_LOAD, NS_CMP2_BODY);
#pragma unroll
    for (int dh = 0; dh < 2; ++dh)
#pragma unroll
        for (int i = 0; i < 16; ++i) { OUTB[(dh * 16 + i) * 512] = g0 * ot[dh][i]; ot[dh][i] = 0.f; }
    if (tb < 16) { const unsigned long long mask = (1ull << (tb + 1)) - 1ull;
        if (lane < 8) { MSK[2 * (8 * wave + lane)] = (unsigned)mask; MSK[2 * (8 * wave + lane) + 1] = (unsigned)(mask >> 32); } }
    else {
        unsigned vb[8], T[8];
#pragma unroll
        for (int tk = 0; tk < 8; ++tk) { const int trow = 8 * wave + tk; vb[tk] = __float_as_uint(OWN[trow * 64 + lane] + SPL[trow * 65 + lane]); T[tk] = 0u; }
        const unsigned long long cm = __ballot((lane >= 1) && (lane <= tb - 2));
#pragma unroll 1
        for (int bit = 30; bit >= 0; --bit) {
#pragma unroll
            for (int tk = 0; tk < 8; ++tk) { const unsigned trial = T[tk] | (1u << bit);
                if (__builtin_popcountll(__ballot(vb[tk] >= trial) & cm) >= 13) T[tk] = trial; } }
#pragma unroll
        for (int tk = 0; tk < 8; ++tk) { const int trow = 8 * wave + tk;
            const unsigned long long gt = __ballot(vb[tk] > T[tk]) & cm; unsigned long long eq = __ballot(vb[tk] == T[tk]) & cm, pick = 0ull;
            for (int need = 13 - __builtin_popcountll(gt); need > 0; --need) { const unsigned long long low = eq & (0ull - eq); pick |= low; eq ^= low; }
            const unsigned long long mask = gt | pick | 1ull | (1ull << tb) | (1ull << (tb - 1));
            if (lane == 0) { MSK[2 * trow] = (unsigned)mask; MSK[2 * trow + 1] = (unsigned)(mask >> 32); } }
    }
    __syncthreads();
    unsigned long long mymask, wunion, bunion;
    { const unsigned lo = MSK[2 * (8 * wave + tokl)], hi = MSK[2 * (8 * wave + tokl) + 1]; mymask = ((unsigned long long)hi << 32) | lo;
      unsigned wl = lo, wh = hi;
      wl |= __shfl_xor(wl, 4); wh |= __shfl_xor(wh, 4); wl |= __shfl_xor(wl, 8); wh |= __shfl_xor(wh, 8); wl |= __shfl_xor(wl, 16); wh |= __shfl_xor(wh, 16);
      wunion = ((unsigned long long)(unsigned)__builtin_amdgcn_readfirstlane(wh) << 32) | (unsigned)__builtin_amdgcn_readfirstlane(wl);
      unsigned bl = MSK[2 * lane], bh = MSK[2 * lane + 1];
#pragma unroll
      for (int o = 1; o < 64; o <<= 1) { bl |= __shfl_xor(bl, o); bh |= __shfl_xor(bh, o); }
      bunion = ((unsigned long long)(unsigned)__builtin_amdgcn_readfirstlane(bh) << 32) | (unsigned)__builtin_amdgcn_readfirstlane(bl);
      bunion &= (tb == 63) ? ~0ull : ((1ull << (tb + 1)) - 1ull); }
    const bf16_t* ksb = proj + (size_t)(b * T_) * DIN + C_KV + 2 * 256 + g * 64 + lch * 8;
#define NS_ROW(j) ((size_t)(64 * (j) + lkey) * DIN)
    {
        m = -1e30f; l = 0.f;
        unsigned long long lcur = bunion, ccur = bunion;
#define NS_SEL_LOAD(KR, VR) { const int jj = lcur ? 63 - __builtin_clzll(lcur) : 0; lcur &= ~(1ull << jj); KR = *(const u32x4*)(ksb + NS_ROW(jj)); VR = *(const u32x4*)(vst + 64 * jj); }
#define NS_SEL_BODY(BUF) { const int j = 63 - __builtin_clzll(ccur); ccur &= ~(1ull << j); unsigned char* buf = (BUF); \
            if ((wunion >> j) & 1ull) { \
                if (j == tb) { ns_qk(buf, qf, qx, kx, c, hf, st, 0.f); ns_mask<1, true, false>(st, (float)(t - 64 * j - 4 * hf)); \
                    ns_softmax<true>(st, slope2 * (float)(64 * j - t), true, m, l, ot, buf + 64 * NS_KP, c, hf); } \
                else { ns_qk(buf, qf, qx, kx, c, hf, st, ((mymask >> j) & 1ull) ? slope2 * (float)(64 * j - t) - m : -INFINITY); \
                    ns_softmax_rel(st, m, l, ot, buf + 64 * NS_KP, c, hf); } } }
        NS_PIPE(__builtin_popcountll(bunion), NS_SEL_LOAD, NS_SEL_BODY);
        l += __shfl_xor(l, 32);
        const float f = g1 / l;
#pragma unroll
        for (int dh = 0; dh < 2; ++dh)
#pragma unroll
            for (int i = 0; i < 16; ++i) { OUTB[(dh * 16 + i) * 512] += f * ot[dh][i]; ot[dh][i] = 0.f; }
    }
    {
        m = -1e30f; l = 0.f;
        const bf16_t* kwb = ksb + 2 * 256;
        const int j0 = max(0, tb - 8);
        int lj = tb, cj = tb;
#define NS_WIN_LOAD(KR, VR) { const int lj_ = max(lj, j0); KR = *(const u32x4*)(kwb + NS_ROW(lj_)); VR = *(const u32x4*)(vwt + 64 * lj_); --lj; }
#define NS_WIN_BODY(BUF) { const int j = cj--; unsigned char* buf = (BUF); \
            if (j == tb) { ns_qk(buf, qf, qx, kx, c, hf, st, 0.f); ns_mask<1, true, false>(st, (float)(t - 64 * j - 4 * hf)); \
                ns_softmax<true>(st, slope2 * (float)(64 * j - t), true, m, l, ot, buf + 64 * NS_KP, c, hf); } \
            else { ns_qk(buf, qf, qx, kx, c, hf, st, slope2 * (float)(64 * j - t) - m); \
                if (j == j0) ns_mask<1, false, true>(st, (float)(t - 64 * j - 4 * hf)); \
                ns_softmax_rel(st, m, l, ot, buf + 64 * NS_KP, c, hf); } }
        NS_PIPE(tb - j0 + 1, NS_WIN_LOAD, NS_WIN_BODY);
        l += __shfl_xor(l, 32);
        const float f = g2 / l;
#pragma unroll
        for (int dh = 0; dh < 2; ++dh)
#pragma unroll
            for (int i = 0; i < 16; ++i) ot[dh][i] = OUTB[(dh * 16 + i) * 512] + f * ot[dh][i];
    }
#undef NS_ROW
#undef NS_CMP_ADDR
#undef NS_PIPE
#undef NS_CMP_LOAD
#undef NS_CMP1_BODY
#undef NS_CMP2_BODY
#undef NS_SEL_LOAD
#undef NS_SEL_BODY
#undef NS_WIN_LOAD
#undef NS_WIN_BODY
    bf16_t* orow = (bf16_t*)(p->ws + WS_MIX) + (size_t)(b * T_ + t) * D_ + hq * 64;
#pragma unroll
    for (int dh = 0; dh < 2; ++dh)
#pragma unroll
        for (int q4 = 0; q4 < 4; ++q4) { u32x2 w; w.x = pk2(ot[dh][4 * q4], ot[dh][4 * q4 + 1]); w.y = pk2(ot[dh][4 * q4 + 2], ot[dh][4 * q4 + 3]);
            *(u32x2*)(orow + dh * 32 + 8 * q4 + 4 * hf) = w; }
}
typedef float f32x4m __attribute__((ext_vector_type(4)));
__device__ __forceinline__ bf16x8 ldfrag(const unsigned char* base, int pitch, int row, int kbyte) { return *(const bf16x8*)(base + row * pitch + kbyte); }
#define MFMA16(a, b, c) __builtin_amdgcn_mfma_f32_16x16x32_bf16((a), (b), (c), 0, 0, 0)
constexpr int GQP = 272, GTP = 144;
constexpr int G_QT = 0, G_KT = 17408, G_KET = 34816, G_VT = 53248, G_ATT = 71680, G_ZS = 80896, G_SEG = 84992;

__device__ __forceinline__ void gla_prep_item2(KP p, int L, int item, unsigned char* smem) {
    const int tid = otid(), lane = tid & 63, wave = tid >> 6, b = item >> 8, n = (item >> 2) & 63, h = item & 3;
    const int fr = lane & 15, fq = lane >> 4;
    float* zs = (float*)(smem + G_ZS); float* segt = (float*)(smem + G_SEG);
    const bf16_t* proj = (const bf16_t*)(p->ws + WS_PROJ);
    const size_t row0 = (size_t)(b * T_ + n * 64);
    const int c = tid & 127, tq = tid >> 7;
    bf16_t qraw[16], kraw[16], vraw[16];
#pragma unroll
    for (int i = 0; i < 16; ++i) { const bf16_t* pr = proj + (row0 + tq * 16 + i) * DIN + h * 128 + c; qraw[i] = pr[C_GQ]; kraw[i] = pr[C_GK]; vraw[i] = pr[C_GV]; }
    for (int i = tid; i < 1024; i += NTHR) { const int t = i >> 4, r = i & 15; zs[i] = bf2f(proj[(row0 + t) * DIN + C_GZ + r]); }
    __syncthreads();
    float loc[16];
    { float w2c[16];
#pragma unroll
      for (int r = 0; r < 16; ++r) w2c[r] = p->in[13][((size_t)L * 16 + r) * 512 + h * 128 + c];
      const float bg = p->in[14][L * 512 + h * 128 + c]; float run = 0.f;
#pragma unroll
      for (int i = 0; i < 16; ++i) { const int t = tq * 16 + i; float x = bg;
#pragma unroll
          for (int r = 0; r < 16; ++r) x += zs[t * 16 + r] * w2c[r];
          const float ey = fexp(-fabsf(x)); const float l1p = (ey > 1e-3f) ? __builtin_amdgcn_logf(1.f + ey) * 0.6931471805599453f : ey - 0.5f * ey * ey;
          const float ls = fminf(x, 0.f) - l1p;
          run += ls * (1.f / 16.f); loc[i] = run; }
      segt[tq * 128 + c] = run; }
    __syncthreads();
    {
        float off = 0.f, bl = 0.f;
#pragma unroll
        for (int s = 0; s < 4; ++s) { const float v = segt[s * 128 + c]; bl += v; if (s < tq) off += v; }
        bf16_t* gqt = (bf16_t*)(p->ws + WS_GQT);
#pragma unroll
        for (int i = 0; i < 16; i += 2) { const int t0 = tq * 16 + i; float ke[2]; bf16_t vv[2];
#pragma unroll
            for (int e = 0; e < 2; ++e) { const int t = t0 + e; const float bc = loc[i + e] + off;
                const float kx = bf2f(kraw[i + e]); const bf16_t qb = f2bf(bf2f(qraw[i + e]) * 0.08838834764831845f * fexp(bc));
                *(bf16_t*)(smem + G_QT + t * GQP + c * 2) = qb; *(bf16_t*)(smem + G_KT + t * GQP + c * 2) = f2bf(kx * fexp(-bc));
                gqt[(row0 + t) * 512 + h * 128 + c] = qb; ke[e] = kx * fexp(bl - bc); vv[e] = vraw[i + e]; }
            *(unsigned*)(smem + G_KET + c * GTP + t0 * 2) = pk2(ke[0], ke[1]);
            *(unsigned*)(smem + G_VT + c * GTP + t0 * 2) = (unsigned)vv[0] | ((unsigned)vv[1] << 16); }
        if (tq == 0) ((float*)(p->ws + WS_GDEC))[(size_t)((b * 64 + n) * 4 + h) * 128 + c] = fexp(bl);
    }
    __syncthreads();
    { const int tt = wave & 3;
#pragma unroll
      for (int si = 0; si < 2; ++si) { const int stile = 2 * (wave >> 2) + si; f32x4m acc = {0.f, 0.f, 0.f, 0.f};
          if (stile <= tt) {
#pragma unroll
              for (int ks = 0; ks < 4; ++ks) acc = MFMA16(ldfrag(smem + G_QT, GQP, tt * 16 + fr, (32 * ks + 8 * fq) * 2), ldfrag(smem + G_KT, GQP, stile * 16 + fr, (32 * ks + 8 * fq) * 2), acc); }
#pragma unroll
          for (int r = 0; r < 4; ++r) { const int t = tt * 16 + fq * 4 + r, s = stile * 16 + fr;
              *(bf16_t*)(smem + G_ATT + t * GTP + s * 2) = (s <= t) ? f2bf(acc[r]) : (bf16_t)0; } } }
    __syncthreads();
    { const int tt = wave & 3; float* goi = (float*)(p->ws + WS_GOI);
#pragma unroll
      for (int vi = 0; vi < 4; ++vi) { const int vt = 4 * (wave >> 2) + vi; f32x4m acc = {0.f, 0.f, 0.f, 0.f};
#pragma unroll
          for (int ks = 0; ks < 2; ++ks) acc = MFMA16(ldfrag(smem + G_ATT, GTP, tt * 16 + fr, (32 * ks + 8 * fq) * 2), ldfrag(smem + G_VT, GTP, vt * 16 + fr, (32 * ks + 8 * fq) * 2), acc);
#pragma unroll
          for (int r = 0; r < 4; ++r) goi[(row0 + tt * 16 + fq * 4 + r) * 512 + h * 128 + vt * 16 + fr] = acc[r]; } }
    { float* gupd = (float*)(p->ws + WS_GUPD) + (size_t)((b * 64 + n) * 4 + h) * 16384;
      const bf16x8 a0 = ldfrag(smem + G_VT, GTP, wave * 16 + fr, (8 * fq) * 2), a1 = ldfrag(smem + G_VT, GTP, wave * 16 + fr, (32 + 8 * fq) * 2);
#pragma unroll
      for (int kt = 0; kt < 8; ++kt) { f32x4m acc = {0.f, 0.f, 0.f, 0.f};
          acc = MFMA16(a0, ldfrag(smem + G_KET, GTP, kt * 16 + fr, (8 * fq) * 2), acc);
          acc = MFMA16(a1, ldfrag(smem + G_KET, GTP, kt * 16 + fr, (32 + 8 * fq) * 2), acc);
#pragma unroll
          for (int r = 0; r < 4; ++r) gupd[(wave * 16 + fq * 4 + r) * 128 + kt * 16 + fr] = acc[r]; } }
    __syncthreads();
}

constexpr int GO_ST = 0, GO_QS = 34816, GO_SS = 52224;
__device__ __forceinline__ void gla_out_item2(KP p, int L, int item, unsigned char* smem) {
    const int tid = otid(), lane = tid & 63, wave = tid >> 6, b = item >> 8, n = (item >> 2) & 63, h = item & 3;
    const int fr = lane & 15, fq = lane >> 4;
    const float* gupd = (const float*)(p->ws + WS_GUPD) + (size_t)((b * 64 + n) * 4 + h) * 16384;
    const bf16_t* gqt = (const bf16_t*)(p->ws + WS_GQT); const float* goi = (const float*)(p->ws + WS_GOI);
    const bf16_t* proj = (const bf16_t*)(p->ws + WS_PROJ); bf16_t* mix = (bf16_t*)(p->ws + WS_MIX);
    const size_t row0 = (size_t)(b * T_ + n * 64);
#pragma unroll
    for (int i = 0; i < 8; ++i) { const int e = tid + 512 * i, v = e >> 5, k4 = (e & 31) * 4; const f32x4 s = *(const f32x4*)(gupd + v * 128 + k4);
        u32x2 o; o.x = pk2(s[0], s[1]); o.y = pk2(s[2], s[3]); *(u32x2*)(smem + GO_ST + v * GQP + k4 * 2) = o; }
#pragma unroll
    for (int i = 0; i < 2; ++i) { const int e = tid + 512 * i, t = e >> 4, k8 = (e & 15) * 8;
        *(u32x4*)(smem + GO_QS + t * GQP + k8 * 2) = *(const u32x4*)(gqt + (row0 + t) * 512 + h * 128 + k8); }
    const int tt = wave & 3, vh = wave >> 2;
    float goiv[4][4]; bf16_t rgv[4][4]; float gnv[4];
#pragma unroll
    for (int vi = 0; vi < 4; ++vi) { const int v = (4 * vh + vi) * 16 + fr; gnv[vi] = p->in[15][L * 512 + h * 128 + v];
#pragma unroll
        for (int r = 0; r < 4; ++r) { const size_t rw = row0 + tt * 16 + fq * 4 + r; goiv[vi][r] = goi[rw * 512 + h * 128 + v]; rgv[vi][r] = proj[rw * DIN + C_GR + h * 128 + v]; } }
    __syncthreads();
    f32x4m acc[4]; float ssq[4] = {0.f, 0.f, 0.f, 0.f};
#pragma unroll
    for (int vi = 0; vi < 4; ++vi) { const int vt = 4 * vh + vi; acc[vi] = (f32x4m){0.f, 0.f, 0.f, 0.f};
#pragma unroll
        for (int ks = 0; ks < 4; ++ks) acc[vi] = MFMA16(ldfrag(smem + GO_QS, GQP, tt * 16 + fr, (32 * ks + 8 * fq) * 2), ldfrag(smem + GO_ST, GQP, vt * 16 + fr, (32 * ks + 8 * fq) * 2), acc[vi]);
#pragma unroll
        for (int r = 0; r < 4; ++r) { acc[vi][r] += goiv[vi][r]; ssq[r] += acc[vi][r] * acc[vi][r]; } }
    float* SS = (float*)(smem + GO_SS);
#pragma unroll
    for (int r = 0; r < 4; ++r) { float s = ssq[r]; s += __shfl_xor(s, 1); s += __shfl_xor(s, 2); s += __shfl_xor(s, 4); s += __shfl_xor(s, 8);
        if (fr == 0) SS[vh * 64 + tt * 16 + fq * 4 + r] = s; }
    __syncthreads();
#pragma unroll
    for (int r = 0; r < 4; ++r) { const int t = tt * 16 + fq * 4 + r; const float rs = rsqrtf((SS[t] + SS[64 + t]) * (1.f / 128.f) + EPS);
#pragma unroll
        for (int vi = 0; vi < 4; ++vi) { const int v = (4 * vh + vi) * 16 + fr; const float rg = bf2f(rgv[vi][r]);
            mix[(row0 + t) * D_ + 1536 + h * 128 + v] = f2bf(acc[vi][r] * rs * gnv[vi] * (rg * sigm(rg))); } }
    __syncthreads();
}

constexpr int LXP = 1040, L_XC = 0, L_A = 66560, L_U = 66560 + 32768;
__device__ __forceinline__ void lru_prep_item2(KP p, int L, int item, unsigned char* smem) {
    const int tid = otid(), lane = tid & 63, wave = tid >> 6, c = tid, b = item >> 6, n = item & 63, fr = lane & 15, fq = lane >> 4;
    const bf16_t* proj = (const bf16_t*)(p->ws + WS_PROJ);
    const int t0 = n * 64;
    { float cw[4];
#pragma unroll
      for (int k = 0; k < 4; ++k) cw[k] = p->in[6][(L * 4 + k) * 512 + c];
      const float cb = p->in[7][L * 512 + c];
      float x0 = (t0 >= 3) ? bf2f(proj[(size_t)(b * T_ + t0 - 3) * DIN + C_LX + c]) : 0.f;
      float x1 = (t0 >= 2) ? bf2f(proj[(size_t)(b * T_ + t0 - 2) * DIN + C_LX + c]) : 0.f;
      float x2 = (t0 >= 1) ? bf2f(proj[(size_t)(b * T_ + t0 - 1) * DIN + C_LX + c]) : 0.f;
#pragma unroll 32
      for (int tt = 0; tt < 64; ++tt) { const float x3 = bf2f(proj[(size_t)(b * T_ + t0 + tt) * DIN + C_LX + c]);
          const float xc = cb + cw[0] * x0 + cw[1] * x1 + cw[2] * x2 + cw[3] * x3; x0 = x1; x1 = x2; x2 = x3;
          *(bf16_t*)(smem + L_XC + tt * LXP + c * 2) = f2bf(xc); } }
    const bf16_t* lwt = (const bf16_t*)(p->ws + WS_LWT);
    bf16x8 bw[2][4][2];
#pragma unroll
    for (int gt = 0; gt < 2; ++gt)
#pragma unroll
        for (int dt = 0; dt < 4; ++dt)
#pragma unroll
            for (int ks = 0; ks < 2; ++ks) bw[gt][dt][ks] = *(const bf16x8*)(lwt + ((size_t)(gt * 8 + wave) * 64 + dt * 16 + fr) * 64 + 32 * ks + 8 * fq);
    float bav[4], biv[4], spv[4];
#pragma unroll
    for (int dt = 0; dt < 4; ++dt) { const int cc = wave * 64 + dt * 16 + fr; bav[dt] = p->in[9][L * 512 + cc]; biv[dt] = p->in[11][L * 512 + cc]; spv[dt] = log1pf(expf(-p->in[12][L * 512 + cc])); }
    float* hl = (float*)(p->ws + WS_LH); float* pp = (float*)(p->ws + WS_LP);
    float* LA = (float*)(smem + L_A); float* LU = (float*)(smem + L_U);
    float hst = 0.f, Pst = 1.f;
    __syncthreads();
    for (int ts = 0; ts < 4; ++ts) {
        const bf16x8 a0 = ldfrag(smem + L_XC, LXP, ts * 16 + fr, (wave * 64 + 8 * fq) * 2), a1 = ldfrag(smem + L_XC, LXP, ts * 16 + fr, (wave * 64 + 32 + 8 * fq) * 2);
#pragma unroll
        for (int dt = 0; dt < 4; ++dt) { f32x4m ra = {0.f, 0.f, 0.f, 0.f}, ri = {0.f, 0.f, 0.f, 0.f};
            ra = MFMA16(a0, bw[0][dt][0], ra); ra = MFMA16(a1, bw[0][dt][1], ra); ri = MFMA16(a0, bw[1][dt][0], ri); ri = MFMA16(a1, bw[1][dt][1], ri);
#pragma unroll
            for (int r = 0; r < 4; ++r) { const int tl = fq * 4 + r, cc = wave * 64 + dt * 16 + fr;
                const float xc = bf2f(*(const bf16_t*)(smem + L_XC + (ts * 16 + tl) * LXP + cc * 2));
                const float rr = sigm(ra[r] + bav[dt]), ig = sigm(ri[r] + biv[dt]); const float log_a = -8.f * rr * spv[dt];
                const float av = fexp(log_a); LA[tl * 512 + cc] = av; LU[tl * 512 + cc] = __builtin_amdgcn_sqrtf(fmaxf(1.f - av * av, 0.f)) * (ig * xc); } }
        __syncthreads();
#pragma unroll
        for (int tl = 0; tl < 16; ++tl) { const float a = LA[tl * 512 + c]; hst = a * hst + LU[tl * 512 + c]; Pst *= a;
            const size_t o = (size_t)(b * T_ + t0 + ts * 16 + tl) * 512 + c; hl[o] = hst; pp[o] = Pst; }
        __syncthreads();
    }
}

__device__ __forceinline__ void compress_item2(KP p, int item, unsigned char* smem) {
    const int tid = otid(), lane = tid & 63, wave = tid >> 6, fr = lane & 15, fq = lane >> 4;
    const int kv = item >> 7, b = (item >> 6) & 1, g = (item >> 4) & 3, nt = item & 15;
    const bf16_t* proj = (const bf16_t*)(p->ws + WS_PROJ);
    const bf16_t* wct = (const bf16_t*)(p->ws + WS_WCT) + (size_t)kv * 64 * 2048;
    const int nrow = min(nt * 16 + fr, NCMP - 1);
    const bf16_t* arow = proj + (size_t)(b * T_ + 16 * nrow) * DIN + C_KV + kv * 256 + g * 64;
    f32x4m acc[4];
#pragma unroll
    for (int ot = 0; ot < 4; ++ot) acc[ot] = (f32x4m){0.f, 0.f, 0.f, 0.f};
#pragma unroll
    for (int kk = 0; kk < 8; ++kk) { const int ks = wave * 8 + kk, l = ks >> 1, d0 = 32 * (ks & 1) + 8 * fq;
        const bf16x8 a = *(const bf16x8*)(arow + (size_t)l * DIN + d0);
#pragma unroll
        for (int ot = 0; ot < 4; ++ot) acc[ot] = MFMA16(a, *(const bf16x8*)(wct + (size_t)(ot * 16 + fr) * 2048 + 32 * ks + 8 * fq), acc[ot]); }
    float* part = (float*)smem;
#pragma unroll
    for (int ot = 0; ot < 4; ++ot)
#pragma unroll
        for (int r = 0; r < 4; ++r) part[wave * 1024 + (fq * 4 + r) * 64 + ot * 16 + fr] = acc[ot][r];
    __syncthreads();
    { const int row = tid >> 5, col = (tid & 31) * 2, nn = nt * 16 + row; float s0 = 0.f, s1 = 0.f;
#pragma unroll
      for (int w = 0; w < 8; ++w) { s0 += part[w * 1024 + row * 64 + col]; s1 += part[w * 1024 + row * 64 + col + 1]; }
      const float* peb = (const float*)(p->ws + WS_PEB) + kv * 64;
      if (kv == 0) { if (nn < NCMP) *(unsigned*)((bf16_t*)(p->ws + WS_KC) + ((size_t)(b * NCMP + nn) * 4 + g) * 64 + col) = pk2(s0 + peb[col], s1 + peb[col + 1]); }
      else { bf16_t* vt = (bf16_t*)(p->ws + WS_VCT) + ((size_t)((b * 4 + g) * 64 + col)) * 256 + nn;
          vt[0] = (nn < NCMP) ? f2bf(s0 + peb[col]) : (bf16_t)0; vt[256] = (nn < NCMP) ? f2bf(s1 + peb[col + 1]) : (bf16_t)0; } }
    __syncthreads();
}
__device__ __forceinline__ void vt_item(KP p, int item, unsigned char* scr, int lane) {
    const int br = item >> 9, b = (item >> 8) & 1, g = (item >> 6) & 3, tt = item & 63;
    const bf16_t* src = (const bf16_t*)(p->ws + WS_PROJ) + (size_t)(b * T_ + tt * 64) * DIN + C_KV + (br ? 5 : 3) * 256 + g * 64;
#pragma unroll
    for (int i = 0; i < 8; ++i) { const int q = lane + 64 * i, row = q >> 3, ch = q & 7; *(u32x4*)(scr + row * 144 + ch * 16) = *(const u32x4*)(src + (size_t)row * DIN + ch * 8); }
    asm volatile("s_waitcnt lgkmcnt(0)" ::: "memory");
    bf16_t* dst = (bf16_t*)(p->ws + (br ? WS_VWT : WS_VST)) + ((size_t)((b * 4 + g) * 64 + lane)) * T_ + tt * 64;
#pragma unroll
    for (int k8 = 0; k8 < 8; ++k8) { unsigned short e[8];
#pragma unroll
        for (int j = 0; j < 8; ++j) e[j] = *(const unsigned short*)(scr + (k8 * 8 + j) * 144 + lane * 2);
        u32x4 w; w.x = e[0] | ((unsigned)e[1] << 16); w.y = e[2] | ((unsigned)e[3] << 16); w.z = e[4] | ((unsigned)e[5] << 16); w.w = e[6] | ((unsigned)e[7] << 16);
        *(u32x4*)(dst + k8 * 8) = w; }
    asm volatile("s_waitcnt lgkmcnt(0)" ::: "memory");
}
__device__ __forceinline__ void convert_small(KP p, int L, unsigned char* smem) {
    const int tid = otid(), lane = tid & 63, wave = tid >> 6;
    float* scr = (float*)smem + wave * TSCR;
    const int gw = blockIdx.x * 8 + wave, NGW = gridDim.x * 8;
    for (int it = gw; it < 64; it += NGW) { const int kv = it >> 5;
        transpose_item(p->in[4] + ((size_t)L * 2 + kv) * 2048 * 64, 2048, 64, (bf16_t*)(p->ws + WS_WCT) + (size_t)kv * 64 * 2048, scr, it & 31, lane); }
    const int gt = blockIdx.x * NTHR + tid, GT = gridDim.x * NTHR;
    for (int e = gt; e < 2 * 8 * 4096; e += GT) { const int gate = e >> 15, r = e & 32767, blk = r >> 12, d = (r >> 6) & 63, cp = r & 63;
        const float* src = (gate ? p->in[10] : p->in[8]) + (size_t)L * 8 * 4096 + blk * 4096 + cp * 64 + d;
        ((bf16_t*)(p->ws + WS_LWT))[e] = f2bf(*src); }
    for (int it = gw; it < 128; it += NGW) { const int kv = it >> 6, o = it & 63;
        const float* W = p->in[4] + ((size_t)L * 2 + kv) * 2048 * 64; const float* pe = p->in[5] + ((size_t)L * 2 + kv) * 2048;
        float s = 0.f;
#pragma unroll 8
        for (int k = lane; k < 2048; k += 64) s += pe[k] * W[(size_t)k * 64 + o];
        s = wave_sum(s);
        if (lane == 0) ((float*)(p->ws + WS_PEB))[it] = s; }
}
#define KPP kparams()
#define WSP (kparams()->ws)
#define U ((bf16_t*)(WSP + WS_U))
#define H ((float*)(WSP + WS_H))
#define E ((bf16_t*)(WSP + WS_E))
#define PB ((bf16_t*)(WSP + WS_PB))
#define PROJ ((bf16_t*)(WSP + WS_PROJ))
#define MIX ((bf16_t*)(WSP + WS_MIX))
#define ACT ((bf16_t*)(WSP + WS_ACT))
#define Y ((bf16_t*)(WSP + WS_Y))
template <int L> __device__ __forceinline__ void layer_body(unsigned char* smem, const XcdBarrier& xb, const int G, const int bx) {
        convert_weights(KPP, L, 31, osm(smem));
        convert_small(KPP, L, osm(smem));
        __syncthreads();
        row_phase(L == 0 ? KPP->in[0] : H, nullptr, nullptr, nullptr, KPP->in[2] + L * D_, U);
        xcd_barrier(xb);
        run_gemm(osm(smem), U, (const bf16_t*)(WSP + WS_WIN), M_, DINP, D_, EpiBf16P<0>{PROJ, DIN, DIN});
        xcd_barrier(xb);
        { const int tid = otid(), wave = tid >> 6, lane = tid & 63; unsigned char* sm = osm(smem); for (int it = bx * 8 + wave; it < 1024; it += G * 8) vt_item(KPP, it, sm + wave * 9216, lane); __syncthreads(); }
        for (int it = bx; it < 128; it += G) lru_prep_item2(KPP, L, it, osm(smem));
        if (G == 256) { if (bx < 128) gla_prep_item2(KPP, L, bx, osm(smem)); else for (int q = 0; q < 3; ++q) gla_prep_item2(KPP, L, 128 + (bx - 128) * 3 + q, osm(smem)); }
        else for (int it = bx; it < 512; it += G) gla_prep_item2(KPP, L, it, osm(smem));
        for (int it = bx; it < 256; it += G) compress_item2(KPP, it, osm(smem));
        xcd_barrier(xb);
        gla_scan(KPP);
        for (int it = bx; it < 512; it += G) nsa_item(KPP, it, osm(smem));
        for (int it = bx; it < 256; it += G) lru_out_item(KPP, it);
        xcd_barrier(xb);
        for (int it = bx; it < 512; it += G) gla_out_item2(KPP, L, it, osm(smem));
        xcd_barrier(xb);
        run_gemm(osm(smem), MIX, (const bf16_t*)(WSP + WS_WOUT), M_, D_, D_, EpiBf16P<0>{Y, D_, D_});
        run_gemm(osm(smem), PB + (size_t)L * M_ * PLE, (const bf16_t*)(WSP + WS_WP), M_, D_, PLE, EpiBf16P<0>{E, D_, D_});
        xcd_barrier(xb);
        row_phase(L == 0 ? KPP->in[0] : H, Y, KPP->in[17] + L * D_, H, KPP->in[18] + L * D_, U);
        xcd_barrier(xb);
        run_gemm(osm(smem), U, (const bf16_t*)(WSP + WS_WUP), M_, DFF, D_, EpiBf16P<1>{ACT, DFF, DFF});
        xcd_barrier(xb);
        run_gemm(osm(smem), ACT, (const bf16_t*)(WSP + WS_WDN), M_, D_, DFF, EpiBf16P<0>{Y, D_, D_});
        xcd_barrier(xb);
        row_phase(H, Y, KPP->in[21] + L * D_, H, nullptr, U);
        xcd_barrier(xb);
        run_gemm(osm(smem), U, (const bf16_t*)(WSP + WS_WG), M_, D_, D_, EpiPle{L == 1 ? KPP->out : H, H, E, D_});
        xcd_barrier(xb);
    }
__global__ void __launch_bounds__(512, 2) mega(Params p_unused) {
    extern __shared__ __attribute__((aligned(16))) unsigned char smem[];
    cg::grid_group grid = cg::this_grid();
    const int G = gridDim.x, bx = blockIdx.x;
    { const int tid = otid(); unsigned* bar0 = (unsigned*)(kparams()->ws + WS_BAR);
      if (bx == 0) for (int i = tid; i < XCD_BAR_WORDS; i += NTHR) bar0[i] = 0u;
      if (tid < 4) ((unsigned*)(smem + LDS_BYTES - 16))[tid] = 0u;
      __threadfence(); }
    grid.sync();
    const XcdBarrier xb = xcd_barrier_post((unsigned*)(kparams()->ws + WS_BAR), (volatile XB_LAS unsigned*)(smem + LDS_BYTES - 16));
    { const int tid = otid(); const f32x4* src = (const f32x4*)KPP->in[1]; u32x2* dst = (u32x2*)PB; const int n4 = 2 * M_ * PLE / 4;
      for (int i = bx * NTHR + tid; i < n4; i += G * NTHR) { const f32x4 v = src[i]; u32x2 o; o.x = pk2(v[0], v[1]); o.y = pk2(v[2], v[3]); dst[i] = o; } }
    layer_body<0>(smem, xb, G, bx);
    layer_body<1>(smem, xb, G, bx);
}
#undef KPP
#undef WSP
#undef U
#undef H
#undef E
#undef PB
#undef PROJ
#undef MIX
#undef ACT
#undef Y
}

extern "C" void kernel_launch(void* const* d_in, const int* in_sizes, int n_in, void* d_out, int out_size, void* d_ws, size_t ws_size, hipStream_t stream) {
    static int grid = 0;
    if (grid == 0) {
        if (n_in != 24 || ws_size < mk::WS_END) { fprintf(stderr, "kernel_launch: unexpected n_in %d / ws %zu\n", n_in, ws_size); grid = -1; return; }
        int dev = 0, cus = 0, per = 0;
        hipGetDevice(&dev); hipDeviceGetAttribute(&cus, hipDeviceAttributeMultiprocessorCount, dev);
        if (hipFuncSetAttribute((const void*)mk::mega, hipFuncAttributeMaxDynamicSharedMemorySize, mk::LDS_BYTES) != hipSuccess) fprintf(stderr, "kernel_launch: hipFuncSetAttribute failed\n");
        if (hipOccupancyMaxActiveBlocksPerMultiprocessor(&per, (const void*)mk::mega, mk::NTHR, mk::LDS_BYTES) != hipSuccess || per < 1) { fprintf(stderr, "kernel_launch: occupancy query says %d\n", per); per = 1; }
        (void)hipGetLastError();
        grid = cus;
    }
    if (grid < 0) return;
    mk::Params p{};
    for (int i = 0; i < 24; ++i) p.in[i] = (const float*)d_in[i];
    p.out = (float*)d_out; p.ws = (unsigned char*)d_ws;
    void* args[] = {&p};
    hipError_t e = hipLaunchCooperativeKernel((const void*)mk::mega, dim3(grid), dim3(mk::NTHR), args, mk::LDS_BYTES, stream);
    if (e != hipSuccess) fprintf(stderr, "kernel_launch: cooperative launch failed: %s (grid %d)\n", hipGetErrorString(e), grid);
}
```

```cpp
#include <hip/hip_runtime.h>
#include <hip/hip_cooperative_groups.h>
#include <cstdio>
namespace cg = cooperative_groups;
namespace pg8 {
#define PG8_LAS __attribute__((address_space(3)))
typedef unsigned short bf16_t;
typedef short bf16x8 __attribute__((ext_vector_type(8)));
typedef float f32x4 __attribute__((ext_vector_type(4)));
typedef unsigned u32x4 __attribute__((ext_vector_type(4)));
constexpr int BM = 256, BK = 64, HALF = 128, HTB = HALF * BK * 2  , STAGE_BYTES = 8 * HTB, NXCD = 8, WGM = 8;

__host__ __device__ __forceinline__ int lds_byte(int r, int c) { const int st = (r >> 4) * 2 + (c >> 5), rr = r & 15, cc = c & 31, ob = rr * 64 + cc * 2; return st * 1024 + (ob ^ (((ob >> 9) & 1) << 5)); }
__host__ __device__ __forceinline__ void stage_rc(int b, int& R, int& C) { const int st = b / 1024, sb = b % 1024, swz = sb ^ (((sb >> 9) & 1) << 5); R = (st >> 1) * 16 + swz / 64; C = (st & 1) * 32 + (swz % 64) / 2; }
__host__ __device__ __forceinline__ int perm32(int rho) { const int n = rho >> 4, i = rho & 15; return 8 * (i >> 2) + 4 * n + (i & 3); }

struct Unit { int pm, pn; };
struct Gemm { const bf16_t* A; const bf16_t* Bt; int M, N, K; };

struct StaticOrder {
    int nM, nN, nwg, G, c;
    __host__ __device__ void init(int M, int N, int G_, int c_) { nM = M / BM; nN = N / BM; nwg = nM * nN; G = G_; c = c_; }
    __host__ __device__ bool next(int i, Unit& u) const {
        const long L = (long)i * G + c; if (L >= nwg) return false;
        int wgid = (int)L; { const int q = nwg / NXCD, r = nwg % NXCD, xcd = wgid % NXCD, off = wgid / NXCD; wgid = (xcd < r ? xcd * (q + 1) : r * (q + 1) + (xcd - r) * q) + off; }
        const int nig = WGM * nN, gid = wgid / nig, fm = gid * WGM, gsz = (nM - fm) < WGM ? (nM - fm) : WGM;
        u.pm = fm + ((wgid % nig) % gsz); u.pn = (wgid % nig) / gsz; return true;
    }
    __device__ __forceinline__ void a_ready(const Unit&) const {}
    __device__ __forceinline__ void done(const Unit&) const {}
};
struct CountedOrder : StaticOrder {
    const unsigned* ready; unsigned need; unsigned* tmo;
    __device__ __forceinline__ void a_ready(const Unit& u) const {
        if (threadIdx.x < 64) {
            const unsigned long long t0 = __builtin_amdgcn_s_memrealtime(); unsigned polls = 0;
            while ((unsigned)__builtin_amdgcn_readfirstlane(__hip_atomic_load(ready + 64 * u.pm, __ATOMIC_RELAXED, __HIP_MEMORY_SCOPE_AGENT)) < need) {
                if ((++polls & 255u) == 0u && __builtin_amdgcn_readfirstlane(__hip_atomic_load(tmo, __ATOMIC_RELAXED, __HIP_MEMORY_SCOPE_AGENT)) != 0u) break;
                if (__builtin_amdgcn_s_memrealtime() - t0 > 2000000ull) {
                    if (threadIdx.x == 0) { unsigned expect = 0u; __hip_atomic_compare_exchange_strong(tmo + 1, &expect, 0x600u | (unsigned)(u.pm & 0xff), __ATOMIC_RELAXED, __ATOMIC_RELAXED, __HIP_MEMORY_SCOPE_AGENT); __hip_atomic_store(tmo, 1u, __ATOMIC_RELAXED, __HIP_MEMORY_SCOPE_AGENT); }
                    break; }
                __builtin_amdgcn_s_sleep(2); }
            __builtin_amdgcn_fence(__ATOMIC_ACQUIRE, "agent");
            asm volatile("s_waitcnt vmcnt(0)" ::: "memory");
        }
#if !defined(BROKEN_HOOK_NO_BARRIER)
        asm volatile("" ::: "memory"); __builtin_amdgcn_s_barrier(); asm volatile("" ::: "memory");
#endif
    }
};

__device__ __forceinline__ unsigned cvt_pk_bf16(float lo, float hi) { unsigned r; asm volatile("v_cvt_pk_bf16_f32 %0, %1, %2" : "=v"(r) : "v"(lo), "v"(hi)); return r; }
typedef float f32x2 __attribute__((ext_vector_type(2)));
__device__ __forceinline__ f32x2 gelu_pk(f32x2 v) {
    const f32x2 av = __builtin_elementwise_abs(v), d = av * 0.2316418882f + 1.0f;
    f32x2 t; t.x = __builtin_amdgcn_rcpf(d.x); t.y = __builtin_amdgcn_rcpf(d.y);
    f32x2 q = t * 0.5307027145f + (-0.7265760135f); q = q * t + 0.7107068705f; q = q * t + (-0.142248368f); q = q * t + 0.127414796f; q = q * t;
    const f32x2 s = (v * v) * (-0.72134752044f);
    f32x2 e; e.x = __builtin_amdgcn_exp2f(s.x); e.y = __builtin_amdgcn_exp2f(s.y);
    const f32x2 m = v * (q * e), r = v - m;
    f32x2 o; o.x = v.x < 0.f ? m.x : r.x; o.y = v.y < 0.f ? m.y : r.y; return o;
}

struct EpiF32 {
    static constexpr bool PERM = false, AFTER_DRAIN = false;
    float* C; int ldc; const float* bias;
    __device__ __forceinline__ void operator()(const f32x4 (&acc)[2][2][4][2], const Unit& u, int wr, int wc, int fr, int fq) const {
        const int row0 = u.pm * BM + wr * 64 + fr, col0 = u.pn * BM + wc * 32 + 4 * fq;
        f32x4 bv[2][2];
#pragma unroll
        for (int bj = 0; bj < 2; ++bj)
#pragma unroll
            for (int n = 0; n < 2; ++n) bv[bj][n] = bias ? *(const f32x4*)(bias + col0 + bj * HALF + n * 16) : (f32x4){0.f, 0.f, 0.f, 0.f};
#pragma unroll
        for (int ai = 0; ai < 2; ++ai)
#pragma unroll
            for (int m = 0; m < 4; ++m) { float* rowp = C + (size_t)(row0 + ai * HALF + m * 16) * ldc + col0;
#pragma unroll
                for (int bj = 0; bj < 2; ++bj)
#pragma unroll
                    for (int n = 0; n < 2; ++n) *(f32x4*)(rowp + bj * HALF + n * 16) = acc[ai][bj][m][n] + bv[bj][n]; }
    }
};
template <int ACT  > struct EpiBf16 {
    static constexpr bool PERM = true, AFTER_DRAIN = false;
    bf16_t* O; int ldc; const float* bias; int split_cols; size_t split_stride;
    __device__ __forceinline__ void operator()(const f32x4 (&acc)[2][2][4][2], const Unit& u, int wr, int wc, int fr, int fq) const {
        const int row0 = u.pm * BM + wr * 64 + fr; int colt = u.pn * BM; bf16_t* base = O;
        if (split_cols) { const int t = colt / split_cols; base += (size_t)t * split_stride; colt -= t * split_cols; }
        const int col0 = colt + wc * 32 + 8 * fq, bcol0 = u.pn * BM + wc * 32 + 8 * fq;
        f32x4 bv[2][2];
#pragma unroll
        for (int bj = 0; bj < 2; ++bj)
#pragma unroll
            for (int n = 0; n < 2; ++n) bv[bj][n] = bias ? *(const f32x4*)(bias + bcol0 + bj * HALF + 4 * n) : (f32x4){0.f, 0.f, 0.f, 0.f};
#pragma unroll
        for (int ai = 0; ai < 2; ++ai)
#pragma unroll
            for (int m = 0; m < 4; ++m) { bf16_t* rowp = base + (size_t)(row0 + ai * HALF + m * 16) * ldc + col0;
#pragma unroll
                for (int bj = 0; bj < 2; ++bj) { f32x4 v0 = acc[ai][bj][m][0] + bv[bj][0], v1 = acc[ai][bj][m][1] + bv[bj][1];
                    if (ACT == 1) { f32x2 a = gelu_pk((f32x2){v0[0], v0[1]}), b = gelu_pk((f32x2){v0[2], v0[3]}), c = gelu_pk((f32x2){v1[0], v1[1]}), d = gelu_pk((f32x2){v1[2], v1[3]});
                        v0 = (f32x4){a.x, a.y, b.x, b.y}; v1 = (f32x4){c.x, c.y, d.x, d.y}; }
                    if (ACT == 2) {
#pragma unroll
                        for (int j = 0; j < 4; ++j) { v0[j] = 0.5f * v0[j] * (1.0f + erff(v0[j] * 0.70710678f)); v1[j] = 0.5f * v1[j] * (1.0f + erff(v1[j] * 0.70710678f)); } }
                    u32x4 w; w.x = cvt_pk_bf16(v0[0], v0[1]); w.y = cvt_pk_bf16(v0[2], v0[3]); w.z = cvt_pk_bf16(v1[0], v1[1]); w.w = cvt_pk_bf16(v1[2], v1[3]);
                    *(u32x4*)(rowp + bj * HALF) = w; } }
    }
};
template <class Epi, class Sched, bool STAMP = false>
__device__ __forceinline__ void gemm_phase(PG8_LAS unsigned char* lds, const Gemm g, const Sched& S, const Epi& E, unsigned long long* stamps) {
    int tid_ = threadIdx.x; asm volatile("" : "+v"(tid_)); int K_ = g.K; asm volatile("" : "+s"(K_));
    const int tid = tid_, wid = __builtin_amdgcn_readfirstlane(tid >> 6), lane = tid & 63, wr = wid >> 2, wc = wid & 3, fr = lane & 15, fq = lane >> 4;
    const int K = K_, nt = K / BK;
    int ts_lo = 0, ts_hi = 0, nts = 0; const unsigned long long rt_entry = STAMP ? (unsigned long long)wall_clock64() : 0ull;
#define PG8_STAMP() do { if (STAMP && wid == 0 && nts < 64) { const unsigned long long _c = (unsigned long long)clock64(); \
        ts_lo = (lane == nts) ? (int)(unsigned)_c : ts_lo; ts_hi = (lane == nts) ? (int)(unsigned)(_c >> 32) : ts_hi; ++nts; } } while (0)
    PG8_STAMP();
    unsigned voffA[2], voffB[2];
#pragma unroll
    for (int i = 0; i < 2; ++i) { int R, C; stage_rc(tid * 16 + i * 8192, R, C); const int Rb = Epi::PERM ? ((R & ~31) + perm32(R & 31)) : R;
        voffA[i] = (unsigned)(R * K + C) * 2u; voffB[i] = (unsigned)(Rb * K + C) * 2u; }
    const size_t kstep = (size_t)(BK * 2);
    const size_t hstep = (size_t)HALF * K * 2;
    const size_t tstep = 2 * hstep;
    const unsigned ldsw = (unsigned)wid * 1024u;
    const int aoff = lds_byte(wr * 64 + fr, fq * 8), boff = lds_byte(wc * 32 + fr, fq * 8);
#define PG8_SA(b, h) (((b) * 2 + (h)) * HTB)
#define PG8_SB(b, h) ((4 + (b) * 2 + (h)) * HTB)
#define PG8_STAGE(bufoff, gbase, voff) do { _Pragma("unroll") for (int _i = 0; _i < 2; ++_i) \
        __builtin_amdgcn_global_load_lds((const unsigned*)((const char*)(gbase) + (voff)[_i]), (PG8_LAS unsigned*)(lds + (bufoff) + ldsw + _i * 8192), 16, 0, 0); } while (0)
#define PG8_LDA(dst, b, h) do { _Pragma("unroll") for (int m = 0; m < 4; ++m) _Pragma("unroll") for (int k = 0; k < 2; ++k) dst[m][k] = *(const PG8_LAS bf16x8*)(lds + PG8_SA(b, h) + aoff + m * 2048 + k * 1024); } while (0)
#define PG8_LDB(dst, b, h) do { _Pragma("unroll") for (int n = 0; n < 2; ++n) _Pragma("unroll") for (int k = 0; k < 2; ++k) dst[n][k] = *(const PG8_LAS bf16x8*)(lds + PG8_SB(b, h) + boff + n * 2048 + k * 1024); } while (0)
#define PG8_MMA(ai, bj, At, Bt) do { __builtin_amdgcn_s_setprio(1); _Pragma("unroll") for (int m = 0; m < 4; ++m) _Pragma("unroll") for (int n = 0; n < 2; ++n) _Pragma("unroll") for (int k = 0; k < 2; ++k) \
        acc[ai][bj][m][n] = __builtin_amdgcn_mfma_f32_16x16x32_bf16(Bt[n][k], At[m][k], acc[ai][bj][m][n], 0, 0, 0); __builtin_amdgcn_s_setprio(0); } while (0)
#define PG8_WAIT_V(n) asm volatile("s_waitcnt vmcnt(" #n ")" ::: "memory")
#define PG8_WAIT_L(n) asm volatile("s_waitcnt lgkmcnt(" #n ")" ::: "memory")
#define PG8_BAR __builtin_amdgcn_s_barrier()
#define PG8_SCHED __builtin_amdgcn_sched_barrier(0)
    Unit cur, nxt; int ui = 0;
    if (!S.next(0, cur)) return;
    f32x4 acc[2][2][4][2];
#pragma unroll
    for (int a = 0; a < 2; ++a)
#pragma unroll
        for (int b = 0; b < 2; ++b)
#pragma unroll
            for (int m = 0; m < 4; ++m)
#pragma unroll
                for (int n = 0; n < 2; ++n) acc[a][b][m][n] = (f32x4){0.f, 0.f, 0.f, 0.f};
    bf16x8 At[4][2], B0[2][2], B1[2][2];
    const char* cA = (const char*)g.A + (size_t)cur.pm * tstep; const char* cB = (const char*)g.Bt + (size_t)cur.pn * tstep;
    S.a_ready(cur);
    PG8_STAGE(PG8_SB(0, 0), cB, voffB); PG8_STAGE(PG8_SA(0, 0), cA, voffA); PG8_STAGE(PG8_SB(0, 1), cB + hstep, voffB); PG8_STAGE(PG8_SA(0, 1), cA + hstep, voffA);
    if (wr == 1) PG8_BAR;
    PG8_WAIT_V(4); PG8_BAR;
    PG8_STAGE(PG8_SB(1, 0), cB + kstep, voffB); PG8_STAGE(PG8_SA(1, 0), cA + kstep, voffA); PG8_STAGE(PG8_SB(1, 1), cB + hstep + kstep, voffB);
    PG8_WAIT_V(6); PG8_BAR;
    PG8_STAMP();
    for (;;) {
        const bool has_next = S.next(ui + 1, nxt);
        const char* nA = has_next ? (const char*)g.A + (size_t)nxt.pm * tstep : cA; const char* nB = has_next ? (const char*)g.Bt + (size_t)nxt.pn * tstep : cB;
        for (int t = 0; t < nt; t += 2) {
            const bool last = (t == nt - 2);
            const char* a1 = cA + (size_t)(t + 1) * kstep;
            const char* a2 = last ? nA : cA + (size_t)(t + 2) * kstep; const char* b2 = last ? nB : cB + (size_t)(t + 2) * kstep;
            const char* a3 = a2 + kstep; const char* b3 = b2 + kstep;
            if (last && has_next) S.a_ready(nxt);
            PG8_LDB(B0, 0, 0); PG8_SCHED; PG8_LDA(At, 0, 0); PG8_STAGE(PG8_SA(1, 1), a1 + hstep, voffA);
            PG8_WAIT_L(8); PG8_BAR; PG8_WAIT_L(0); PG8_MMA(0, 0, At, B0); PG8_BAR; PG8_SCHED;
            PG8_LDB(B1, 0, 1); PG8_STAGE(PG8_SB(0, 0), b2, voffB);
            PG8_BAR; PG8_WAIT_L(0); PG8_MMA(0, 1, At, B1); PG8_BAR;
            PG8_LDA(At, 0, 1); PG8_STAGE(PG8_SA(0, 0), a2, voffA);
            PG8_BAR; PG8_WAIT_L(0); PG8_MMA(1, 0, At, B0); PG8_BAR; PG8_SCHED;
            PG8_STAGE(PG8_SB(0, 1), b2 + hstep, voffB);
            PG8_WAIT_V(6); PG8_BAR; PG8_MMA(1, 1, At, B1); PG8_BAR;
            PG8_LDB(B0, 1, 0); PG8_SCHED; PG8_LDA(At, 1, 0); PG8_STAGE(PG8_SA(0, 1), a2 + hstep, voffA);
            PG8_WAIT_L(8); PG8_BAR; PG8_WAIT_L(0); PG8_MMA(0, 0, At, B0); PG8_BAR; PG8_SCHED;
            PG8_LDB(B1, 1, 1); PG8_STAGE(PG8_SB(1, 0), b3, voffB);
            PG8_BAR; PG8_WAIT_L(0); PG8_MMA(0, 1, At, B1); PG8_BAR;
            PG8_LDA(At, 1, 1); PG8_STAGE(PG8_SA(1, 0), a3, voffA);
            PG8_BAR; PG8_WAIT_L(0); PG8_MMA(1, 0, At, B0); PG8_BAR; PG8_SCHED;
            PG8_STAGE(PG8_SB(1, 1), b3 + hstep, voffB);
            PG8_WAIT_V(6); PG8_BAR; PG8_MMA(1, 1, At, B1); PG8_BAR;
        }
        PG8_STAMP();
        if constexpr (!Epi::AFTER_DRAIN) { E(acc, cur, wr, wc, fr, fq); S.done(cur); }
        PG8_STAMP();
        if (!has_next) break;
#pragma unroll
        for (int a = 0; a < 2; ++a)
#pragma unroll
            for (int b = 0; b < 2; ++b)
#pragma unroll
                for (int m = 0; m < 4; ++m)
#pragma unroll
                    for (int n = 0; n < 2; ++n) acc[a][b][m][n] = (f32x4){0.f, 0.f, 0.f, 0.f};
        cur = nxt; cA = nA; cB = nB; ++ui;
    }
    PG8_WAIT_V(0);
    if (wr == 0) PG8_BAR;
    PG8_BAR;
    if constexpr (Epi::AFTER_DRAIN) { E.fused(acc, cur, wr, wc, fr, fq, lds, wid, lane); S.done(cur); }
    PG8_STAMP();
    if (STAMP && wid == 0) { stamps[lane] = lane < nts ? (((unsigned long long)(unsigned)ts_hi << 32) | (unsigned)ts_lo) : 0ull;
        if (lane == 62) stamps[62] = rt_entry; if (lane == 63) stamps[63] = (unsigned long long)wall_clock64(); }
#undef PG8_STAMP
#undef PG8_SA
#undef PG8_SB
#undef PG8_STAGE
#undef PG8_LDA
#undef PG8_LDB
#undef PG8_MMA
#undef PG8_WAIT_V
#undef PG8_WAIT_L
#undef PG8_BAR
#undef PG8_SCHED
}
}
#define XB_TMO      128
#define XB_XCNT(j)  (256  + 64 * (j))
#define XB_XSUB(j)  (1280 + 64 * (j))
#define XB_XGEN(j)  (2304 + 64 * (j))
#define XB_TOP      3328
#define XB_TOPGEN   3392
#define XCD_BAR_WORDS 3456
#define XB_SPIN_CAP (1u << 18)
#define XB_LAS __attribute__((address_space(3)))

__device__ __forceinline__ unsigned xb_ld(unsigned* p)              { return __hip_atomic_load(p, __ATOMIC_RELAXED, __HIP_MEMORY_SCOPE_AGENT); }
__device__ __forceinline__ unsigned xb_add(unsigned* p, unsigned v) { return __hip_atomic_fetch_add(p, v, __ATOMIC_RELAXED, __HIP_MEMORY_SCOPE_AGENT); }
__device__ __forceinline__ unsigned xb_xcc_id() { return (unsigned)__builtin_amdgcn_s_getreg((3 << 11) | 20) & 0xFu; }
#define XB_SPIN(cond, bar) do { unsigned _sp = 0; while (cond) { __builtin_amdgcn_s_sleep(1); \
    if ((++_sp & 255u) == 0u) { if (xb_ld(&(bar)[XB_TMO])) break; if (_sp > XB_SPIN_CAP) { atomicAdd(&(bar)[XB_TMO], 1u); break; } } } } while (0)

struct XcdBarrier {
    unsigned* bar; unsigned x;
    volatile XB_LAS unsigned* st;
};

__device__ __forceinline__ XcdBarrier xcd_barrier_post(unsigned* bar, volatile XB_LAS unsigned* st) {
    XcdBarrier b; b.bar = bar; b.x = xb_xcc_id(); b.st = st;
    if (threadIdx.x == 0) (void)xb_add(&bar[XB_XCNT(b.x)], 1u);
    return b;
}
__device__ __forceinline__ void xcd_barrier_complete(unsigned* bar, unsigned x, unsigned& nloc, unsigned& nx) {
    const unsigned G = gridDim.x * gridDim.y * gridDim.z;
    unsigned sum, cnt, mine, sp = 0u;
    for (;;) {
        sum = 0u; cnt = 0u; mine = 0u;
#pragma unroll
        for (unsigned j = 0; j < 16; ++j) { const unsigned c = xb_ld(&bar[XB_XCNT(j)]); sum += c; cnt += (c > 0u) ? 1u : 0u; mine = (j == x) ? c : mine; }
        if (sum == G) break;
        __builtin_amdgcn_s_sleep(1);
        if ((++sp & 255u) == 0u) { if (xb_ld(&bar[XB_TMO])) break; if (sp > XB_SPIN_CAP) { atomicAdd(&bar[XB_TMO], 1u); break; } }
    }
    nloc = mine > 0u ? mine : 1u; nx = cnt > 0u ? cnt : 1u;
}

__device__ __forceinline__ void xcd_barrier(const XcdBarrier& b) {
    asm volatile("s_waitcnt vmcnt(0)" ::: "memory");
    __syncthreads();
    if (threadIdx.x == 0) {
        unsigned* bar = b.bar;
        __builtin_amdgcn_s_waitcnt(0);
        unsigned nloc = b.st[0], nx = b.st[1];
        if (nloc == 0u) { xcd_barrier_complete(bar, b.x, nloc, nx); b.st[0] = nloc; b.st[1] = nx; }
        const unsigned old = xb_add(&bar[XB_XSUB(b.x)], 1u);
        const unsigned gen = old / nloc;
        if (old + 1u == (gen + 1u) * nloc) {
            __builtin_amdgcn_fence(__ATOMIC_RELEASE, "agent");
            asm volatile("s_waitcnt vmcnt(0)" ::: "memory");
            const unsigned og = xb_add(&bar[XB_TOP], 1u);
            const unsigned tg = og / nx;
            if (og + 1u == (tg + 1u) * nx) xb_add(&bar[XB_TOPGEN], 1u);
            else XB_SPIN(xb_ld(&bar[XB_TOPGEN]) == tg, bar);
            __builtin_amdgcn_fence(__ATOMIC_ACQUIRE, "agent");
            xb_add(&bar[XB_XGEN(b.x)], 1u);
            asm volatile("s_waitcnt vmcnt(0)" ::: "memory");
        } else {
            XB_SPIN(xb_ld(&bar[XB_XGEN(b.x)]) == gen, bar);
            __builtin_amdgcn_fence(__ATOMIC_ACQUIRE, "agent");
            asm volatile("s_waitcnt vmcnt(0)" ::: "memory");
        }
    }
    __syncthreads();
}

namespace mk {
typedef unsigned short bf16_t;
typedef float f32x4 __attribute__((ext_vector_type(4)));
typedef unsigned u32x4 __attribute__((ext_vector_type(4)));
typedef unsigned u32x2 __attribute__((ext_vector_type(2)));
#define MK_LAS __attribute__((address_space(3)))

constexpr int NTHR = 512, LDS_BYTES = 147456;
constexpr int T_ = 4096, B_ = 2, M_ = 8192, D_ = 2048, DIN = 5696, DINP = 5888, DFF = 8192, PLE = 256;
constexpr int C_Q = 0, C_KV = 1024, C_G = 2560, C_LX = 2608, C_LY = 3120, C_GQ = 3632, C_GK = 4144, C_GV = 4656, C_GR = 5168, C_GZ = 5680;
constexpr int NCMP = 255;
constexpr float EPS = 1e-6f;
constexpr size_t MB = 1u << 20;
constexpr size_t WS_WIN = 0, WS_WOUT = 23 * MB, WS_WUP = 31 * MB, WS_WDN = 63 * MB, WS_WG = 95 * MB, WS_WP = 103 * MB,
                 WS_U = 104 * MB, WS_H = 136 * MB, WS_E = 200 * MB, WS_PB = 232 * MB,
                 WS_PROJ = 240 * MB, WS_MIX = 329 * MB, WS_LH = 361 * MB, WS_LP = 377 * MB, WS_GQT = 393 * MB, WS_GOI = 401 * MB,
                 WS_GUPD = 417 * MB, WS_GDEC = 449 * MB, WS_KC = 450 * MB, WS_VC = 450 * MB + 512 * 1024, WS_WCT = 451 * MB, WS_LWT = 451 * MB + 512 * 1024, WS_PEB = 451 * MB + 768 * 1024, WS_BAR = 452 * MB, WS_VST = 453 * MB, WS_VWT = 457 * MB, WS_VCT = 461 * MB, WS_END = 462 * MB,
                 WS_ACT = 240 * MB, WS_Y = 384 * MB;

struct Params { const float* in[24]; float* out; unsigned char* ws; };
typedef const __attribute__((address_space(4))) Params* KP;
__device__ __forceinline__ KP kparams() { KP k = (KP)__builtin_amdgcn_kernarg_segment_ptr(); asm volatile("" : "+s"(k)); return k; }

__device__ __forceinline__ float bf2f(bf16_t b) { return __uint_as_float(((unsigned)b) << 16); }
typedef float f32x2n __attribute__((ext_vector_type(2)));
typedef __bf16 bf16x2n __attribute__((ext_vector_type(2)));
__device__ __forceinline__ unsigned pk2(float lo, float hi) { const f32x2n v = {lo, hi}; return __builtin_bit_cast(unsigned, __builtin_convertvector(v, bf16x2n)); }
__device__ __forceinline__ bf16_t f2bf(float f) { return (bf16_t)(pk2(f, f) & 0xffffu); }
__device__ __forceinline__ float bflo(unsigned u) { return __uint_as_float(u << 16); }
__device__ __forceinline__ float bfhi(unsigned u) { return __uint_as_float(u & 0xffff0000u); }
__device__ __forceinline__ float wave_sum(float v) {
#pragma unroll
    for (int o = 1; o < 64; o <<= 1) v += __shfl_xor(v, o);
    return v;
}
__device__ __forceinline__ int otid() { int t = threadIdx.x; asm volatile("" : "+v"(t)); return t; }
__device__ __forceinline__ unsigned char* osm(unsigned char* s) { unsigned off = 0; asm volatile("" : "+s"(off)); return s + off; }
__device__ __forceinline__ float fexp(float x) { return __builtin_amdgcn_exp2f(x * 1.4426950408889634f); }
__device__ __forceinline__ float sigm(float x) { return __builtin_amdgcn_rcpf(1.f + fexp(-x)); }

template <int ACT> struct EpiBf16P {
    static constexpr bool PERM = true, AFTER_DRAIN = false;
    bf16_t* O; int ldc; int ncols;
    __device__ __forceinline__ void operator()(const pg8::f32x4 (&acc)[2][2][4][2], const pg8::Unit& u, int wr, int wc, int fr, int fq) const {
        const int row0 = u.pm * 256 + wr * 64 + fr, col0 = u.pn * 256 + wc * 32 + 8 * fq;
#pragma unroll
        for (int ai = 0; ai < 2; ++ai)
#pragma unroll
            for (int m = 0; m < 4; ++m) { bf16_t* rowp = O + (size_t)(row0 + ai * 128 + m * 16) * ldc + col0;
#pragma unroll
                for (int bj = 0; bj < 2; ++bj) { pg8::f32x4 v0 = acc[ai][bj][m][0], v1 = acc[ai][bj][m][1];
                    if (ACT == 1) {
#pragma unroll
                        for (int j = 0; j < 4; ++j) { float a = fmaxf(v0[j], 0.f), b = fmaxf(v1[j], 0.f); v0[j] = a * a; v1[j] = b * b; } }
                    u32x4 w; w.x = pk2(v0[0], v0[1]); w.y = pk2(v0[2], v0[3]); w.z = pk2(v1[0], v1[1]); w.w = pk2(v1[2], v1[3]);
                    if (col0 + bj * 128 < ncols) *(u32x4*)(rowp + bj * 128) = w; } }
    }
};
struct EpiF32 {
    static constexpr bool PERM = false, AFTER_DRAIN = false;
    float* C; int ldc;
    __device__ __forceinline__ void operator()(const pg8::f32x4 (&acc)[2][2][4][2], const pg8::Unit& u, int wr, int wc, int fr, int fq) const {
        const int row0 = u.pm * 256 + wr * 64 + fr, col0 = u.pn * 256 + wc * 32 + 4 * fq;
#pragma unroll
        for (int ai = 0; ai < 2; ++ai)
#pragma unroll
            for (int m = 0; m < 4; ++m) { float* rowp = C + (size_t)(row0 + ai * 128 + m * 16) * ldc + col0;
#pragma unroll
                for (int bj = 0; bj < 2; ++bj)
#pragma unroll
                    for (int n = 0; n < 2; ++n) *(pg8::f32x4*)(rowp + bj * 128 + n * 16) = acc[ai][bj][m][n]; }
    }
};
struct EpiPle {
    static constexpr bool PERM = false, AFTER_DRAIN = false;
    float* out; const float* h2; const bf16_t* e; int ldc;
    __device__ __forceinline__ void operator()(const pg8::f32x4 (&acc)[2][2][4][2], const pg8::Unit& u, int wr, int wc, int fr, int fq) const {
        const int row0 = u.pm * 256 + wr * 64 + fr, col0 = u.pn * 256 + wc * 32 + 4 * fq;
#pragma unroll
        for (int ai = 0; ai < 2; ++ai)
#pragma unroll
            for (int m = 0; m < 4; ++m) { const size_t ro = (size_t)(row0 + ai * 128 + m * 16) * ldc + col0;
#pragma unroll
                for (int bj = 0; bj < 2; ++bj)
#pragma unroll
                    for (int n = 0; n < 2; ++n) { const size_t o = ro + bj * 128 + n * 16;
                        const pg8::f32x4 hv = *(const pg8::f32x4*)(h2 + o); const u32x2 ev = *(const u32x2*)(e + o); const pg8::f32x4 a = acc[ai][bj][m][n];
                        pg8::f32x4 r; r[0] = hv[0] + sigm(a[0]) * bflo(ev.x); r[1] = hv[1] + sigm(a[1]) * bfhi(ev.x);
                        r[2] = hv[2] + sigm(a[2]) * bflo(ev.y); r[3] = hv[3] + sigm(a[3]) * bfhi(ev.y);
                        *(pg8::f32x4*)(out + o) = r; } }
    }
};
template <class Epi> __device__ __forceinline__ void run_gemm(unsigned char* smem, const bf16_t* A, const bf16_t* Bt, int M, int N, int K, const Epi& E) {
    pg8::Gemm g{A, Bt, M, N, K}; pg8::StaticOrder S; S.init(M, N, (int)gridDim.x, (int)blockIdx.x);
    pg8::gemm_phase<Epi, pg8::StaticOrder, false>((PG8_LAS unsigned char*)smem, g, S, E, nullptr);
}

constexpr int TSCR = 64 * 65;
__device__ __forceinline__ void transpose_item(const float* __restrict__ W, int K, int N, bf16_t* __restrict__ WT, float* scr_f, int item, int lane) {
    unsigned* scr = (unsigned*)scr_f;
    const int nblk = N / 64, kb = item / nblk, nb = item % nblk, k0 = 64 * kb, n0 = 64 * nb;
    const int lr = lane >> 4, lc = (lane & 15) * 4;
    f32x4 va[8], vb[8];
#pragma unroll
    for (int i = 0; i < 8; ++i) { const float* src = W + (size_t)(k0 + 8 * i + 2 * lr) * N + n0 + lc;
        va[i] = __builtin_nontemporal_load((const f32x4*)src); vb[i] = __builtin_nontemporal_load((const f32x4*)(src + N)); }
#pragma unroll
    for (int i = 0; i < 8; ++i) { unsigned* d = scr + (4 * i + lr) * 65 + lc;
        d[0] = pk2(va[i][0], vb[i][0]); d[1] = pk2(va[i][1], vb[i][1]); d[2] = pk2(va[i][2], vb[i][2]); d[3] = pk2(va[i][3], vb[i][3]); }
    asm volatile("s_waitcnt lgkmcnt(0)" ::: "memory");
    const int c = lane & 7;
#pragma unroll
    for (int j = 0; j < 8; ++j) { const int n = (lane >> 3) + 8 * j; const unsigned* s = scr + (4 * c) * 65 + n;
        u32x4 o; o.x = s[0 * 65]; o.y = s[1 * 65]; o.z = s[2 * 65]; o.w = s[3 * 65];
        *(u32x4*)(WT + (size_t)(n0 + n) * K + k0 + 8 * c) = o; }
    asm volatile("s_waitcnt lgkmcnt(0)" ::: "memory");
}
__device__ __forceinline__ void convert_weights(KP p, int L, int which, unsigned char* smem) {
    const int tid = otid(), lane = tid & 63, wave = tid >> 6;
    float* scr = (float*)smem + wave * TSCR;
    const int gw = blockIdx.x * 8 + wave, NGW = gridDim.x * 8;
    unsigned char* ws = p->ws;
    constexpr int I_IN = 32 * 89, I_OUT = 32 * 32, I_UP = 32 * 128, I_DN = 128 * 32, I_G = 32 * 32, I_P = 4 * 32;
    if (which & 1) { for (int it = gw; it < I_IN; it += NGW) transpose_item(p->in[3] + (size_t)L * D_ * DIN, D_, DIN, (bf16_t*)(ws + WS_WIN), scr, it, lane);
        u32x4* z = (u32x4*)(ws + WS_WIN + (size_t)DIN * D_ * 2); const int nz = (DINP - DIN) * D_ * 2 / 16;
        for (int i = blockIdx.x * NTHR + tid; i < nz; i += gridDim.x * NTHR) z[i] = (u32x4){0u, 0u, 0u, 0u}; }
    if (which & 2) for (int it = gw; it < I_OUT; it += NGW) transpose_item(p->in[16] + (size_t)L * D_ * D_, D_, D_, (bf16_t*)(ws + WS_WOUT), scr, it, lane);
    if (which & 4) for (int it = gw; it < I_UP; it += NGW) transpose_item(p->in[19] + (size_t)L * D_ * DFF, D_, DFF, (bf16_t*)(ws + WS_WUP), scr, it, lane);
    if (which & 8) for (int it = gw; it < I_DN; it += NGW) transpose_item(p->in[20] + (size_t)L * DFF * D_, DFF, D_, (bf16_t*)(ws + WS_WDN), scr, it, lane);
    if (which & 16) { for (int it = gw; it < I_G; it += NGW) transpose_item(p->in[22] + (size_t)L * D_ * D_, D_, D_, (bf16_t*)(ws + WS_WG), scr, it, lane);
        for (int it = gw; it < I_P; it += NGW) transpose_item(p->in[23] + (size_t)L * PLE * D_, PLE, D_, (bf16_t*)(ws + WS_WP), scr, it, lane); }
    __syncthreads();
}

__device__ __forceinline__ void row_phase(const float* __restrict__ h_in, const bf16_t* __restrict__ y, const float* __restrict__ g_post, float* __restrict__ h_out,
                                          const float* __restrict__ g_pre, bf16_t* __restrict__ u_out) {
    const int tid = otid(), lane = tid & 63, wave = tid >> 6;
    for (int row = blockIdx.x * 8 + wave; row < M_; row += gridDim.x * 8) {
        const f32x4* hp = (const f32x4*)(h_in + (size_t)row * D_) + lane;
        f32x4 hv[8];
#pragma unroll
        for (int j = 0; j < 8; ++j) hv[j] = hp[64 * j];
        if (y) {
            const u32x2* yp = (const u32x2*)(y + (size_t)row * D_) + lane; f32x4 yv[8]; float ss = 0.f;
#pragma unroll
            for (int j = 0; j < 8; ++j) { const u32x2 yr = yp[64 * j]; yv[j][0] = bflo(yr.x); yv[j][1] = bfhi(yr.x); yv[j][2] = bflo(yr.y); yv[j][3] = bfhi(yr.y); ss += yv[j][0] * yv[j][0] + yv[j][1] * yv[j][1] + yv[j][2] * yv[j][2] + yv[j][3] * yv[j][3]; }
            const float r = rsqrtf(wave_sum(ss) * (1.f / D_) + EPS);
            f32x4* op = (f32x4*)(h_out + (size_t)row * D_) + lane;
#pragma unroll
            for (int j = 0; j < 8; ++j) { const f32x4 g = ((const f32x4*)g_post)[lane + 64 * j]; hv[j] = hv[j] + yv[j] * r * g; op[64 * j] = hv[j]; }
        }
        float r2 = 1.f;
        if (g_pre) { float ss = 0.f;
#pragma unroll
            for (int j = 0; j < 8; ++j) ss += hv[j][0] * hv[j][0] + hv[j][1] * hv[j][1] + hv[j][2] * hv[j][2] + hv[j][3] * hv[j][3];
            r2 = rsqrtf(wave_sum(ss) * (1.f / D_) + EPS); }
        u32x2* up = (u32x2*)(u_out + (size_t)row * D_) + lane;
#pragma unroll
        for (int j = 0; j < 8; ++j) { f32x4 v = hv[j] * r2; if (g_pre) v = v * ((const f32x4*)g_pre)[lane + 64 * j];
            u32x2 o; o.x = pk2(v[0], v[1]); o.y = pk2(v[2], v[3]); up[64 * j] = o; }
    }
}
__device__ __forceinline__ float dot64(const float (&q)[64], const bf16_t* __restrict__ kp) {
    const u32x4* p4 = (const u32x4*)kp; float s = 0.f;
#pragma unroll
    for (int c = 0; c < 8; ++c) { const u32x4 v = p4[c];
        s += q[8 * c + 0] * bflo(v.x) + q[8 * c + 1] * bfhi(v.x) + q[8 * c + 2] * bflo(v.y) + q[8 * c + 3] * bfhi(v.y)
           + q[8 * c + 4] * bflo(v.z) + q[8 * c + 5] * bfhi(v.z) + q[8 * c + 6] * bflo(v.w) + q[8 * c + 7] * bfhi(v.w); }
    return s;
}
__device__ __forceinline__ void axpy64(float (&o)[64], float sc, float pw, const bf16_t* __restrict__ vp) {
    const u32x4* p4 = (const u32x4*)vp;
#pragma unroll
    for (int c = 0; c < 8; ++c) { const u32x4 v = p4[c];
        o[8 * c + 0] = o[8 * c + 0] * sc + pw * bflo(v.x); o[8 * c + 1] = o[8 * c + 1] * sc + pw * bfhi(v.x);
        o[8 * c + 2] = o[8 * c + 2] * sc + pw * bflo(v.y); o[8 * c + 3] = o[8 * c + 3] * sc + pw * bfhi(v.y);
        o[8 * c + 4] = o[8 * c + 4] * sc + pw * bflo(v.z); o[8 * c + 5] = o[8 * c + 5] * sc + pw * bfhi(v.z);
        o[8 * c + 6] = o[8 * c + 6] * sc + pw * bflo(v.w); o[8 * c + 7] = o[8 * c + 7] * sc + pw * bfhi(v.w); }
}

__device__ __forceinline__ void compress_item(KP p, int L, int w, int lane) {
    const int kv = w / 2040, r1 = w % 2040, b = r1 / 1020, r2 = r1 % 1020, n = r2 >> 2, g = r2 & 3;
    const float* W = p->in[4] + ((size_t)L * 2 + kv) * 2048 * 64;
    const float* pe = p->in[5] + ((size_t)L * 2 + kv) * 2048;
    const bf16_t* src = (const bf16_t*)(p->ws + WS_PROJ) + ((size_t)(b * T_ + 16 * n)) * DIN + C_KV + kv * 256 + g * 64;
    float acc = 0.f;
    for (int l = 0; l < 32; ++l) { const bf16_t* row = src + (size_t)l * DIN;
#pragma unroll 8
        for (int dd = 0; dd < 64; ++dd) { const float a = bf2f(row[dd]) + pe[l * 64 + dd]; acc += a * W[(size_t)(l * 64 + dd) * 64 + lane]; } }
    bf16_t* dst = (bf16_t*)(p->ws + (kv ? WS_VC : WS_KC));
    dst[((size_t)(b * NCMP + n) * 4 + g) * 64 + lane] = f2bf(acc);
}

__device__ __forceinline__ void nsa_naive_item(KP p, int item, unsigned char* smem) {
    const int tid = otid(), lane = tid & 63;
    const int b = item >> 7, t = (item & 127) * 32 + (tid >> 4), hq = tid & 15, g = hq >> 2, hh = hq & 3;
    const bf16_t* proj = (const bf16_t*)(p->ws + WS_PROJ);
    const bf16_t* prow = proj + (size_t)(b * T_ + t) * DIN;
    const bf16_t* kc = (const bf16_t*)(p->ws + WS_KC); const bf16_t* vc = (const bf16_t*)(p->ws + WS_VC);
    float* impp = (float*)smem + (tid >> 2) * 64;
    float q[64];
    { const u32x4* qp = (const u32x4*)(prow + C_Q + hq * 64);
#pragma unroll
      for (int c = 0; c < 8; ++c) { const u32x4 v = qp[c]; q[8*c+0] = 0.125f * bflo(v.x); q[8*c+1] = 0.125f * bfhi(v.x); q[8*c+2] = 0.125f * bflo(v.y); q[8*c+3] = 0.125f * bfhi(v.y);
          q[8*c+4] = 0.125f * bflo(v.z); q[8*c+5] = 0.125f * bfhi(v.z); q[8*c+6] = 0.125f * bflo(v.w); q[8*c+7] = 0.125f * bfhi(v.w); } }
    const float slope = exp2f(-0.5f * (float)(hq + 1));
    const float g0 = sigm(bf2f(prow[C_G + hq * 3 + 0])), g1 = sigm(bf2f(prow[C_G + hq * 3 + 1])), g2 = sigm(bf2f(prow[C_G + hq * 3 + 2]));
    float outv[64];
#pragma unroll
    for (int d = 0; d < 64; ++d) outv[d] = 0.f;
    if (hh == 0) { for (int j = 0; j < 64; ++j) impp[j] = 0.f; }
    const int nvalid = (t >= 31) ? ((t - 31) / 16 + 1) : 0;
    {
        float m = -1e30f, l = 0.f;
        for (int n = 0; n < nvalid; ++n) { const float s = dot64(q, kc + ((size_t)(b * NCMP + n) * 4 + g) * 64) - slope * (float)(t - (16 * n + 31));
            const float mn = fmaxf(m, s); l = l * expf(m - mn) + expf(s - mn); m = mn; }
        const float il = (l > 0.f) ? 1.f / l : 0.f;
        for (int n = 0; n < nvalid; ++n) { const size_t ko = ((size_t)(b * NCMP + n) * 4 + g) * 64;
            const float s = dot64(q, kc + ko) - slope * (float)(t - (16 * n + 31));
            const float pw = expf(s - m) * il;
            axpy64(outv, 1.f, pw * g0, vc + ko);
            float ps = pw; ps += __shfl_xor(ps, 1); ps += __shfl_xor(ps, 2);
            if (hh == 0) { impp[n >> 2] += ps; if ((n & 3) == 3 && (n >> 2) < 63) impp[(n >> 2) + 1] += ps; } }
    }
    const int tb = t >> 6;
    unsigned mlo = 0u, mhi = 0u;
    if (hh == 0) {
        unsigned long long mask;
        if (tb < 16) mask = (1ull << (tb + 1)) - 1ull;
        else { mask = 1ull | (1ull << tb) | (1ull << (tb - 1));
            for (int r = 0; r < 13; ++r) { int best = 1; float bv = -1.f;
                for (int j = 1; j <= tb - 2; ++j) { const float v = impp[j]; if (!((mask >> j) & 1ull) && v > bv) { bv = v; best = j; } }
                mask |= 1ull << best; } }
        mlo = (unsigned)mask; mhi = (unsigned)(mask >> 32);
    }
    mlo = __shfl(mlo, lane & ~3); mhi = __shfl(mhi, lane & ~3);
    const unsigned long long mask = ((unsigned long long)mhi << 32) | mlo;
    {
        float m = -1e30f, l = 0.f;
        const bf16_t* kb = proj + (size_t)(b * T_) * DIN + C_KV + 2 * 256 + g * 64; const bf16_t* vb = kb + 256;
        for (int j = 0; j <= tb; ++j) { if (!((mask >> j) & 1ull)) continue;
            const int pend = min(t, 64 * j + 63);
            for (int pos = 64 * j; pos <= pend; ++pos) { const float s = dot64(q, kb + (size_t)pos * DIN) - slope * (float)(t - pos);
                const float mn = fmaxf(m, s); l = l * expf(m - mn) + expf(s - mn); m = mn; } }
        const float f = g1 / l;
        for (int j = 0; j <= tb; ++j) { if (!((mask >> j) & 1ull)) continue;
            const int pend = min(t, 64 * j + 63);
            for (int pos = 64 * j; pos <= pend; ++pos) { const float s = dot64(q, kb + (size_t)pos * DIN) - slope * (float)(t - pos);
                axpy64(outv, 1.f, f * expf(s - m), vb + (size_t)pos * DIN); } }
    }
    {
        float m = -1e30f, l = 0.f;
        const bf16_t* kb = proj + (size_t)(b * T_) * DIN + C_KV + 4 * 256 + g * 64; const bf16_t* vb = kb + 256;
        const int p0 = max(0, t - 511);
        for (int pos = p0; pos <= t; ++pos) { const float s = dot64(q, kb + (size_t)pos * DIN) - slope * (float)(t - pos);
            const float mn = fmaxf(m, s); l = l * expf(m - mn) + expf(s - mn); m = mn; }
        const float f = g2 / l;
        for (int pos = p0; pos <= t; ++pos) { const float s = dot64(q, kb + (size_t)pos * DIN) - slope * (float)(t - pos);
            axpy64(outv, 1.f, f * expf(s - m), vb + (size_t)pos * DIN); }
    }
    u32x4* op = (u32x4*)((bf16_t*)(p->ws + WS_MIX) + (size_t)(b * T_ + t) * D_ + hq * 64);
#pragma unroll
    for (int c = 0; c < 8; ++c) { u32x4 w; w.x = pk2(outv[8*c], outv[8*c+1]); w.y = pk2(outv[8*c+2], outv[8*c+3]); w.z = pk2(outv[8*c+4], outv[8*c+5]); w.w = pk2(outv[8*c+6], outv[8*c+7]); op[c] = w; }
}

__device__ __forceinline__ void lru_prep_item(KP p, int L, int item, unsigned char* smem) {
    const int c = otid(), b = item >> 6, n = item & 63;
    float* xs = (float*)smem;
    const bf16_t* proj = (const bf16_t*)(p->ws + WS_PROJ);
    const float lam = p->in[12][L * 512 + c]; const float sp = log1pf(expf(-lam));
    float cw[4];
#pragma unroll
    for (int k = 0; k < 4; ++k) cw[k] = p->in[6][(L * 4 + k) * 512 + c];
    const float cb = p->in[7][L * 512 + c], ba = p->in[9][L * 512 + c], bi = p->in[11][L * 512 + c];
    const int blk = c >> 6, d = c & 63;
    const float* wa = p->in[8] + (size_t)L * 8 * 4096 + blk * 4096 + d; const float* wi = p->in[10] + (size_t)L * 8 * 4096 + blk * 4096 + d;
    float* hl = (float*)(p->ws + WS_LH); float* pp = (float*)(p->ws + WS_LP);
    float h = 0.f, P = 1.f;
    const int t0 = n * 64;
    float x0 = (t0 >= 3) ? bf2f(proj[(size_t)(b * T_ + t0 - 3) * DIN + C_LX + c]) : 0.f;
    float x1 = (t0 >= 2) ? bf2f(proj[(size_t)(b * T_ + t0 - 2) * DIN + C_LX + c]) : 0.f;
    float x2 = (t0 >= 1) ? bf2f(proj[(size_t)(b * T_ + t0 - 1) * DIN + C_LX + c]) : 0.f;
    for (int tt = 0; tt < 64; ++tt) { const int t = t0 + tt;
        const float x3 = bf2f(proj[(size_t)(b * T_ + t) * DIN + C_LX + c]);
        const float xc = cb + cw[0] * x0 + cw[1] * x1 + cw[2] * x2 + cw[3] * x3;
        x0 = x1; x1 = x2; x2 = x3;
        float* xb = xs + (tt & 1) * 512; xb[c] = xc;
        __syncthreads();
        float ra = ba, ri = bi;
#pragma unroll 8
        for (int k = 0; k < 64; ++k) { const float xv = xb[blk * 64 + k]; ra += xv * wa[k * 64]; ri += xv * wi[k * 64]; }
        const float r = sigm(ra), ig = sigm(ri);
        const float log_a = -8.f * r * sp; const float a = expf(log_a);
        const float u = sqrtf(-expm1f(2.f * log_a)) * (ig * xc);
        h = a * h + u; P *= a;
        hl[(size_t)(b * T_ + t) * 512 + c] = h; pp[(size_t)(b * T_ + t) * 512 + c] = P;
    }
    __syncthreads();
}
__device__ __forceinline__ float gelu_tanh(float x) { const float u = 0.7978845608028654f * (x + 0.044715f * x * x * x); const float th = 1.f - 2.f * __builtin_amdgcn_rcpf(1.f + fexp(2.f * u)); return 0.5f * x * (1.f + th); }
__device__ __forceinline__ void lru_out_item(KP p, int item) {
    const int c = otid(), b = item >> 7, n = (item >> 1) & 63, hc = item & 1;
    const float* hl = (const float*)(p->ws + WS_LH); const float* pp = (const float*)(p->ws + WS_LP);
    const bf16_t* proj = (const bf16_t*)(p->ws + WS_PROJ); bf16_t* mix = (bf16_t*)(p->ws + WS_MIX);
    float carry = 0.f;
#pragma unroll 16
    for (int m = 0; m < n; ++m) { const size_t o = (size_t)(b * T_ + m * 64 + 63) * 512 + c; carry = pp[o] * carry + hl[o]; }
#pragma unroll 16
    for (int tt = 0; tt < 32; ++tt) { const size_t row = (size_t)(b * T_ + n * 64 + hc * 32 + tt);
        const float h = hl[row * 512 + c] + pp[row * 512 + c] * carry;
        const float y = bf2f(proj[row * DIN + C_LY + c]);
        mix[row * D_ + 1024 + c] = f2bf(h * gelu_tanh(y)); }
}

constexpr int GP = 130;
__device__ __forceinline__ void gla_prep_item(KP p, int L, int item, unsigned char* smem) {
    const int tid = otid(), b = item >> 8, n = (item >> 2) & 63, h = item & 3;
    float* Bc = (float*)smem;
    bf16_t* Qt = (bf16_t*)(smem + 32768);
    bf16_t* Kt = Qt + 64 * GP; bf16_t* Ke = Kt + 64 * GP; bf16_t* Vs = Ke + 64 * GP;
    float* Att = (float*)(smem + 99328);
    float* zs = (float*)(smem + 115968);
    float* segt = (float*)(smem + 120064);
    const bf16_t* proj = (const bf16_t*)(p->ws + WS_PROJ);
    const size_t row0 = (size_t)(b * T_ + n * 64);
    for (int i = tid; i < 1024; i += NTHR) { const int t = i >> 4, r = i & 15; zs[i] = bf2f(proj[(row0 + t) * DIN + C_GZ + r]); }
    __syncthreads();
    { const int c = tid & 127, seg = tid >> 7; float w2c[16];
#pragma unroll
      for (int r = 0; r < 16; ++r) w2c[r] = p->in[13][((size_t)L * 16 + r) * 512 + h * 128 + c];
      const float bg = p->in[14][L * 512 + h * 128 + c]; float run = 0.f;
      for (int i = 0; i < 16; ++i) { const int t = seg * 16 + i; float x = bg;
#pragma unroll
          for (int r = 0; r < 16; ++r) x += zs[t * 16 + r] * w2c[r];
          const float ls = fminf(x, 0.f) - log1pf(expf(-fabsf(x)));
          run += ls * (1.f / 16.f); Bc[t * 128 + c] = run; }
      segt[seg * 128 + c] = run; }
    __syncthreads();
    { const int c = tid & 127, seg = tid >> 7; float off = 0.f; for (int s = 0; s < seg; ++s) off += segt[s * 128 + c];
      if (seg > 0) for (int i = 0; i < 16; ++i) Bc[(seg * 16 + i) * 128 + c] += off; }
    __syncthreads();
    bf16_t* gqt = (bf16_t*)(p->ws + WS_GQT); float* gdec = (float*)(p->ws + WS_GDEC);
    for (int i = tid; i < 8192; i += NTHR) { const int t = i >> 7, c = i & 127; const bf16_t* pr = proj + (row0 + t) * DIN + h * 128 + c;
        const float bc = Bc[t * 128 + c], bl = Bc[63 * 128 + c];
        const float qv = bf2f(pr[C_GQ]) * 0.08838834764831845f * expf(bc), kv = bf2f(pr[C_GK]);
        const bf16_t qb = f2bf(qv);
        Qt[t * GP + c] = qb; Kt[t * GP + c] = f2bf(kv * expf(-bc)); Ke[t * GP + c] = f2bf(kv * expf(bl - bc)); Vs[t * GP + c] = pr[C_GV];
        gqt[(row0 + t) * 512 + h * 128 + c] = qb;
        if (t == 63) gdec[(size_t)((b * 64 + n) * 4 + h) * 128 + c] = expf(bl); }
    __syncthreads();
    { const int t = tid >> 3, sg = tid & 7; const unsigned* qr = (const unsigned*)(Qt + t * GP);
      for (int i = 0; i < 8; ++i) { const int s = sg * 8 + i; float a = 0.f;
          if (s <= t) { const unsigned* kr = (const unsigned*)(Kt + s * GP);
#pragma unroll 8
              for (int k = 0; k < 64; ++k) { const unsigned qa = qr[k], ka = kr[k]; a += bflo(qa) * bflo(ka) + bfhi(qa) * bfhi(ka); } }
          Att[t * 65 + s] = a; } }
    __syncthreads();
    { const int v = tid & 127, tg = tid >> 7; float* goi = (float*)(p->ws + WS_GOI);
      for (int i = 0; i < 16; ++i) { const int t = tg * 16 + i; float a = 0.f;
          for (int s = 0; s <= t; ++s) a += Att[t * 65 + s] * bf2f(Vs[s * GP + v]);
          goi[(row0 + t) * 512 + h * 128 + v] = a; } }
    { const int k = tid & 127, vg = tid >> 7; float acc[32];
#pragma unroll
      for (int i = 0; i < 32; ++i) acc[i] = 0.f;
      for (int s = 0; s < 64; ++s) { const float ke = bf2f(Ke[s * GP + k]); const unsigned* vr = (const unsigned*)(Vs + s * GP + vg * 32);
#pragma unroll
          for (int i = 0; i < 16; ++i) { const unsigned vv = vr[i]; acc[2 * i] += bflo(vv) * ke; acc[2 * i + 1] += bfhi(vv) * ke; } }
      float* gupd = (float*)(p->ws + WS_GUPD) + (size_t)((b * 64 + n) * 4 + h) * 16384;
#pragma unroll
      for (int i = 0; i < 32; ++i) gupd[(vg * 32 + i) * 128 + k] = acc[i]; }
    __syncthreads();
}
__device__ __forceinline__ void gla_scan(KP p) {
    float* gupd = (float*)(p->ws + WS_GUPD); const float* gdec = (const float*)(p->ws + WS_GDEC);
    const int tid = otid();
    for (int e = blockIdx.x * NTHR + tid; e < 131072; e += gridDim.x * NTHR) {
        const int b = e >> 16, h = (e >> 14) & 3, vk = e & 16383, k = e & 127; float S = 0.f;
#pragma unroll 1
        for (int n0 = 0; n0 < 64; n0 += 32) { float u[32], d[32];
#pragma unroll
            for (int i = 0; i < 32; ++i) { const size_t bi = (size_t)((b * 64 + n0 + i) * 4 + h); u[i] = gupd[bi * 16384 + vk]; d[i] = gdec[bi * 128 + k]; }
#pragma unroll
            for (int i = 0; i < 32; ++i) { const size_t bi = (size_t)((b * 64 + n0 + i) * 4 + h); gupd[bi * 16384 + vk] = S; S = d[i] * S + u[i]; } }
    }
}
__device__ __forceinline__ void gla_out_item(KP p, int L, int item, unsigned char* smem) {
    const int tid = otid(), lane = tid & 63, wave = tid >> 6, b = item >> 8, n = (item >> 2) & 63, h = item & 3;
    float* ST = (float*)smem;
    float* Qs = (float*)(smem + 66048);
    const float* gupd = (const float*)(p->ws + WS_GUPD) + (size_t)((b * 64 + n) * 4 + h) * 16384;
    const bf16_t* gqt = (const bf16_t*)(p->ws + WS_GQT); const float* goi = (const float*)(p->ws + WS_GOI);
    const bf16_t* proj = (const bf16_t*)(p->ws + WS_PROJ); bf16_t* mix = (bf16_t*)(p->ws + WS_MIX);
    const size_t row0 = (size_t)(b * T_ + n * 64);
    for (int i = tid; i < 16384; i += NTHR) ST[(i >> 7) * 129 + (i & 127)] = gupd[i];
    for (int i = tid; i < 8192; i += NTHR) Qs[i] = bf2f(gqt[(row0 + (i >> 7)) * 512 + h * 128 + (i & 127)]);
    __syncthreads();
    const float gn0 = p->in[15][L * 512 + h * 128 + lane], gn1 = p->in[15][L * 512 + h * 128 + lane + 64];
    for (int ti = 0; ti < 8; ++ti) { const int t = wave * 8 + ti; const float* qr = Qs + t * 128; const float* s0 = ST + lane * 129; const float* s1 = ST + (lane + 64) * 129;
        float o0 = 0.f, o1 = 0.f;
#pragma unroll 8
        for (int k = 0; k < 128; ++k) { const float qv = qr[k]; o0 += qv * s0[k]; o1 += qv * s1[k]; }
        o0 += goi[(row0 + t) * 512 + h * 128 + lane]; o1 += goi[(row0 + t) * 512 + h * 128 + lane + 64];
        const float r = rsqrtf(wave_sum(o0 * o0 + o1 * o1) * (1.f / 128.f) + EPS);
        const float r0 = bf2f(proj[(row0 + t) * DIN + C_GR + h * 128 + lane]), r1 = bf2f(proj[(row0 + t) * DIN + C_GR + h * 128 + lane + 64]);
        mix[(row0 + t) * D_ + 1536 + h * 128 + lane] = f2bf(o0 * r * gn0 * (r0 * sigm(r0)));
        mix[(row0 + t) * D_ + 1536 + h * 128 + lane + 64] = f2bf(o1 * r * gn1 * (r1 * sigm(r1))); }
    __syncthreads();
}
typedef short bf16x8 __attribute__((ext_vector_type(8)));
typedef float f32x16 __attribute__((ext_vector_type(16)));
__device__ __forceinline__ unsigned cvtpk(float lo, float hi) { return pk2(lo, hi); }
__device__ __forceinline__ float fexp2(float x) { return __builtin_amdgcn_exp2f(x); }
constexpr int NS_KP = 144, NS_VP = 136;
constexpr int NS_BUF = 64 * NS_KP + 64 * NS_VP;
constexpr int NS_OWN = 36864, NS_SPL = NS_OWN + 64 * 64 * 4, NS_MSK = NS_SPL + 64 * 65 * 4, NS_OUTB = 73728;

__device__ __forceinline__ void ns_pv(const unsigned char* vbuf, const bf16x8 (&pb)[2][2], int c, int hf, f32x16 (&ot)[2]) {
#pragma unroll
    for (int kh = 0; kh < 2; ++kh)
#pragma unroll
        for (int s2 = 0; s2 < 2; ++s2)
#pragma unroll
            for (int dh = 0; dh < 2; ++dh) { const unsigned char* rp = vbuf + (dh * 32 + c) * NS_VP + (kh * 32 + 16 * s2 + 4 * hf) * 2;
                const u32x2 lo = *(const u32x2*)rp, hi = *(const u32x2*)(rp + 16);
                u32x4 av; av.x = lo.x; av.y = lo.y; av.z = hi.x; av.w = hi.y;
                ot[dh] = __builtin_amdgcn_mfma_f32_32x32x16_bf16(__builtin_bit_cast(bf16x8, av), pb[kh][s2], ot[dh], 0, 0, 0); }
}
__device__ __forceinline__ void ns_pack(const f32x16 (&st)[2], bf16x8 (&pb)[2][2]) {
#pragma unroll
    for (int kh = 0; kh < 2; ++kh)
#pragma unroll
        for (int s2 = 0; s2 < 2; ++s2) { u32x4 w; w.x = cvtpk(st[kh][8 * s2 + 0], st[kh][8 * s2 + 1]); w.y = cvtpk(st[kh][8 * s2 + 2], st[kh][8 * s2 + 3]);
            w.z = cvtpk(st[kh][8 * s2 + 4], st[kh][8 * s2 + 5]); w.w = cvtpk(st[kh][8 * s2 + 6], st[kh][8 * s2 + 7]); pb[kh][s2] = __builtin_bit_cast(bf16x8, w); }
}
__device__ __forceinline__ void ns_store_tile(unsigned char* buf, int tid, const u32x4& kr, const u32x4& vr) {
    const int row = tid >> 3, ch = tid & 7;
    *(u32x4*)(buf + row * NS_KP + ch * 16) = kr;
    *(u32x2*)(buf + 64 * NS_KP + row * NS_VP + ch * 16) = (u32x2){vr.x, vr.y}; *(u32x2*)(buf + 64 * NS_KP + row * NS_VP + ch * 16 + 8) = (u32x2){vr.z, vr.w};
}
typedef unsigned u32x2s __attribute__((ext_vector_type(2)));
__device__ __forceinline__ float dpp_xor1(float x) { return __builtin_bit_cast(float, __builtin_amdgcn_mov_dpp(__builtin_bit_cast(int, x), 0xB1, 0xF, 0xF, true)); }
__device__ __forceinline__ float dpp_xor2(float x) { return __builtin_bit_cast(float, __builtin_amdgcn_mov_dpp(__builtin_bit_cast(int, x), 0x4E, 0xF, 0xF, true)); }
__device__ __forceinline__ float half_max(float x) { const u32x2s r = __builtin_amdgcn_permlane32_swap(__builtin_bit_cast(unsigned, x), __builtin_bit_cast(unsigned, x), false, false); return fmaxf(__builtin_bit_cast(float, r.x), __builtin_bit_cast(float, r.y)); }
__device__ __forceinline__ float half_sum(float x) { const u32x2s r = __builtin_amdgcn_permlane32_swap(__builtin_bit_cast(unsigned, x), __builtin_bit_cast(unsigned, x), false, false); return __builtin_bit_cast(float, r.x) + __builtin_bit_cast(float, r.y); }
__device__ __forceinline__ float lane_read(float x, int i) { return __builtin_bit_cast(float, __builtin_amdgcn_readlane(__builtin_bit_cast(int, x), i)); }
__device__ __forceinline__ float vsubf(float a, float b) { return a - b; }
__device__ __forceinline__ float vaddf(float a, float b) { return a + b; }
__device__ __forceinline__ float vmulf(float a, float b) { return a * b; }
__device__ __forceinline__ void ns_qk(const unsigned char* kbuf, const bf16x8 (&qf)[4], const bf16x8& qx, const bf16x8 (&kx)[2], int c, int hf, f32x16 (&st)[2], float cinit) {
#pragma unroll
    for (int kh = 0; kh < 2; ++kh) {
#pragma unroll
        for (int i = 0; i < 16; ++i) st[kh][i] = cinit;
        st[kh] = __builtin_amdgcn_mfma_f32_32x32x16_bf16(kx[kh], qx, st[kh], 0, 0, 0); }
#pragma unroll
    for (int s = 0; s < 4; ++s)
#pragma unroll
        for (int kh = 0; kh < 2; ++kh) { const bf16x8 a = *(const bf16x8*)(kbuf + (kh * 32 + c) * NS_KP + (16 * s + 8 * hf) * 2);
            st[kh] = __builtin_amdgcn_mfma_f32_32x32x16_bf16(a, qf[s], st[kh], 0, 0, 0); }
}
template <int KM, bool LOWER, bool UPPER> __device__ __forceinline__ void ns_mask(f32x16 (&st)[2], float d0f) {
    asm volatile("" ::: "memory");
    const float d0u = d0f - 511.f;
#pragma unroll
    for (int kh = 0; kh < 2; ++kh)
#pragma unroll
        for (int i = 0; i < 16; ++i) { const float kc = (float)(KM * (kh * 32 + (i & 3) + 8 * (i >> 2)));
            bool ok = true; if (LOWER) ok = ok && (kc <= d0f); if (UPPER) ok = ok && (kc >= d0u);
            st[kh][i] = ok ? st[kh][i] : -INFINITY; }
}
__device__ __forceinline__ float ns_tilemax(const f32x16 (&st)[2]) {
    float mx = st[0][0];
#pragma unroll
    for (int kh = 0; kh < 2; ++kh)
#pragma unroll
        for (int i = 0; i < 16; ++i) mx = fmaxf(mx, st[kh][i]);
    return fmaxf(mx, __shfl_xor(mx, 32));
}
__device__ __forceinline__ float ns_exp(f32x16 (&st)[2], float mref) {
    float ps[4] = {0.f, 0.f, 0.f, 0.f};
#pragma unroll
    for (int kh = 0; kh < 2; ++kh)
#pragma unroll
        for (int i = 0; i < 16; ++i) { const float pw = fexp2(vsubf(st[kh][i], mref)); st[kh][i] = pw; ps[i & 3] = vaddf(ps[i & 3], pw); }
    return vaddf(vaddf(ps[0], ps[1]), vaddf(ps[2], ps[3]));
}
template <bool PV> __device__ __forceinline__ void ns_softmax(f32x16 (&st)[2], float base, bool lanevalid, float& m, float& l, f32x16 (&ot)[2], const unsigned char* vbuf, int c, int hf) {
    const float mxp = ns_tilemax(st); const float mx = lanevalid ? mxp + base : -INFINITY;
    const float mn = (mx > m + 8.f) ? mx : m; const float alpha = fexp2(m - mn); m = mn;
    const float ps = ns_exp(st, lanevalid ? mn - base : INFINITY);
    l = l * alpha + ps;
    if (PV) {
        if (__builtin_amdgcn_ballot_w64(alpha != 1.f) != 0ull) {
#pragma unroll
            for (int dh = 0; dh < 2; ++dh)
#pragma unroll
                for (int i = 0; i < 16; ++i) ot[dh][i] = vmulf(ot[dh][i], alpha); }
        bf16x8 pb[2][2]; ns_pack(st, pb); ns_pv(vbuf, pb, c, hf, ot);
    }
}
__device__ __forceinline__ void ns_softmax_rel(f32x16 (&st)[2], float& m, float& l, f32x16 (&ot)[2], const unsigned char* vbuf, int c, int hf) {
    float mxh = st[0][0];
#pragma unroll
    for (int kh = 0; kh < 2; ++kh)
#pragma unroll
        for (int i = 0; i < 16; ++i) mxh = fmaxf(mxh, st[kh][i]);
    if (__builtin_amdgcn_ballot_w64(mxh > 8.f) != 0ull) {
        const float mxp = fmaxf(mxh, __shfl_xor(mxh, 32));
        const float delta = (mxp > 8.f) ? mxp : 0.f; const float alpha = fexp2(-delta); m += delta; l *= alpha;
#pragma unroll
        for (int kh = 0; kh < 2; ++kh)
#pragma unroll
            for (int i = 0; i < 16; ++i) st[kh][i] -= delta;
#pragma unroll
        for (int dh = 0; dh < 2; ++dh)
#pragma unroll
            for (int i = 0; i < 16; ++i) ot[dh][i] *= alpha;
    }
    float ps[4] = {0.f, 0.f, 0.f, 0.f};
#pragma unroll
    for (int kh = 0; kh < 2; ++kh)
#pragma unroll
        for (int i = 0; i < 16; ++i) { const float pw = fexp2(st[kh][i]); st[kh][i] = pw; ps[i & 3] += pw; }
    l += (ps[0] + ps[1]) + (ps[2] + ps[3]);
    bf16x8 pb[2][2]; ns_pack(st, pb); ns_pv(vbuf, pb, c, hf, ot);
}

__device__ __forceinline__ void ns_cmp2_tail(f32x16 (&st)[2], f32x16 (&ot)[2], const unsigned char* buf, int ti, int c, int hf, int hh, int wave, int tokl, float* OWN, float* SPL) {
#pragma unroll
    for (int kh = 0; kh < 2; ++kh)
#pragma unroll
        for (int i = 0; i < 16; ++i) st[kh][i] = fexp2(st[kh][i]);
#pragma unroll
    for (int kh = 0; kh < 2; ++kh)
#pragma unroll
        for (int q4 = 0; q4 < 4; ++q4) { float qs = (st[kh][4 * q4] + st[kh][4 * q4 + 1]) + (st[kh][4 * q4 + 2] + st[kh][4 * q4 + 3]); float pl = st[kh][4 * q4 + 3];
            qs += dpp_xor1(qs); qs += dpp_xor2(qs); pl += dpp_xor1(pl); pl += dpp_xor2(pl);
            const int j = 16 * ti + 8 * kh + 2 * q4 + hf;
            if (hh == 0 && j < 64) { OWN[(8 * wave + tokl) * 64 + j] = qs; SPL[(8 * wave + tokl) * 65 + j + 1] = pl; } }
    bf16x8 pb[2][2]; ns_pack(st, pb); ns_pv(buf + 64 * NS_KP, pb, c, hf, ot);
}
__device__ __forceinline__ void nsa_item(KP p, int item, unsigned char* smem) {
    const int tid = otid(), lane = tid & 63, wave = tid >> 6, c = lane & 31, hf = lane >> 5, tokl = c >> 2, hh = c & 3;
    const int rnd = item >> 8, r8 = item & 255, b = r8 & 1, g0_ = (r8 >> 1) & 3, g = rnd == 0 ? g0_ : 3 - g0_, tbh = r8 >> 3, tb = rnd == 0 ? 63 - tbh : tbh;
    const int t = 64 * tb + 8 * wave + tokl, hq = g * 4 + hh;
    const bf16_t* proj = (const bf16_t*)(p->ws + WS_PROJ);
    const bf16_t* prow = proj + (size_t)(b * T_ + t) * DIN;
    const bf16_t* kc = (const bf16_t*)(p->ws + WS_KC); const bf16_t* vct = (const bf16_t*)(p->ws + WS_VCT);
    const float LOG2E = 1.4426950408889634f;
    const float slope2 = exp2f(-0.5f * (float)(hq + 1)) * LOG2E, scl = 0.125f * LOG2E;
    bf16x8 qf[4];
#pragma unroll
    for (int s = 0; s < 4; ++s) { const u32x4 qr = *(const u32x4*)(prow + C_Q + hq * 64 + 16 * s + 8 * hf); u32x4 w;
        w.x = cvtpk(bflo(qr.x) * scl, bfhi(qr.x) * scl); w.y = cvtpk(bflo(qr.y) * scl, bfhi(qr.y) * scl); w.z = cvtpk(bflo(qr.z) * scl, bfhi(qr.z) * scl); w.w = cvtpk(bflo(qr.w) * scl, bfhi(qr.w) * scl);
        qf[s] = __builtin_bit_cast(bf16x8, w); }
    bf16x8 qx, kx[2], kx16[2];
    { const unsigned shi = f2bf(slope2); const unsigned slo = f2bf(slope2 - bf2f((bf16_t)shi)); u32x4 w = {0u, 0u, 0u, 0u}; if (hf == 0) w.x = shi | (slo << 16); qx = __builtin_bit_cast(bf16x8, w);
#pragma unroll
      for (int kh = 0; kh < 2; ++kh) { const unsigned k1 = f2bf((float)(kh * 32 + c)), k16 = f2bf((float)(16 * (kh * 32 + c))); u32x4 a = {0u, 0u, 0u, 0u}, b16 = {0u, 0u, 0u, 0u};
          if (hf == 0) { a.x = k1 | (k1 << 16); b16.x = k16 | (k16 << 16); } kx[kh] = __builtin_bit_cast(bf16x8, a); kx16[kh] = __builtin_bit_cast(bf16x8, b16); } }
    const float g0 = sigm(bf2f(prow[C_G + hq * 3 + 0])), g1 = sigm(bf2f(prow[C_G + hq * 3 + 1])), g2 = sigm(bf2f(prow[C_G + hq * 3 + 2]));
    float* OWN = (float*)(smem + NS_OWN); float* SPL = (float*)(smem + NS_SPL); unsigned* MSK = (unsigned*)(smem + NS_MSK);
    for (int i = tid; i < 64 * 64 + 64 * 65; i += NTHR) OWN[i] = 0.f;
    float* OUTB = (float*)(smem + NS_OUTB) + tid;
    f32x16 ot[2], st[2];
#pragma unroll
    for (int dh = 0; dh < 2; ++dh)
#pragma unroll
        for (int i = 0; i < 16; ++i) ot[dh][i] = 0.f;
    const int lkey = tid >> 3, lch = tid & 7;
    const bf16_t* vst = (const bf16_t*)(p->ws + WS_VST) + ((size_t)((b * 4 + g) * 64 + lkey)) * T_ + lch * 8;
    const bf16_t* vwt = (const bf16_t*)(p->ws + WS_VWT) + ((size_t)((b * 4 + g) * 64 + lkey)) * T_ + lch * 8;
#define NS_PIPE(NT, LOADNEXT, COMPUTE) do { const int _n = (NT); u32x4 k0r, v0r, k1r, v1r; \
        LOADNEXT(k0r, v0r); LOADNEXT(k1r, v1r); \
        ns_store_tile(smem, tid, k0r, v0r); LOADNEXT(k0r, v0r); \
        __syncthreads(); \
        for (int _k = 0; _k < _n; _k += 2) {     \
            COMPUTE(smem); \
            ns_store_tile(smem + NS_BUF, tid, k1r, v1r); LOADNEXT(k1r, v1r); \
            __syncthreads(); \
            if (_k + 1 < _n) { COMPUTE((smem + NS_BUF)); } \
            ns_store_tile(smem, tid, k0r, v0r); LOADNEXT(k0r, v0r); \
            __syncthreads(); } } while (0)
    const int ncmp_t = (4 * tb + 3 + 63) >> 6;
    float m = -1e30f, l = 0.f;
    const float d0c = (float)(t - 31 - 64 * hf);
#define NS_CMP_ADDR(ti) ((((size_t)(b * NCMP + min(64 * (ti) + lkey, NCMP - 1))) * 4 + g) * 64 + lch * 8)
    int lti = 0, cti = 0;
#define NS_CMP_LOAD(KR, VR) { const int lt_ = min(lti, ncmp_t - 1); KR = *(const u32x4*)(kc + NS_CMP_ADDR(lt_)); VR = *(const u32x4*)(vct + ((size_t)((b * 4 + g) * 64 + lkey)) * 256 + 64 * lt_ + lch * 8); ++lti; }
#define NS_CMP1_BODY(BUF) { const int ti = cti++; unsigned char* buf = (BUF); \
        ns_qk(buf, qf, qx, kx16, c, hf, st, 0.f); \
        const float d0f = d0c - 1024.f * (float)ti; \
        if (!(16 * (64 * ti + 63) + 31 <= 64 * tb + 8 * wave)) ns_mask<16, true, false>(st, d0f); \
        ns_softmax<false>(st, slope2 * (1024.f * (float)ti - (float)(t - 31)), true, m, l, ot, buf, c, hf); }
    NS_PIPE(ncmp_t, NS_CMP_LOAD, NS_CMP1_BODY);
    l += __shfl_xor(l, 32);
    const float mrefc = (l > 0.f) ? m + __log2f(l) : INFINITY;
    lti = 0; cti = 0;
#define NS_CMP2_BODY(BUF) { const int ti = cti++; unsigned char* buf = (BUF); \
        ns_qk(buf, qf, qx, kx16, c, hf, st, slope2 * (1024.f * (float)ti - (float)(t - 31)) - mrefc);     \
        const float d0f = d0c - 1024.f * (float)ti; \
        if (!(16 * (64 * ti + 63) + 31 <= 64 * tb + 8 * wave)) ns_mask<16, true, false>(st, d0f); \
        ns_cmp2_tail(st, ot, buf, ti, c, hf, hh, wave, tokl, OWN, SPL); }
    NS_PIPE(ncmp_t, NS_CMP_LOAD, NS_CMP2_BODY);
#pragma unroll
    for (int dh = 0; dh < 2; ++dh)
#pragma unroll
        for (int i = 0; i < 16; ++i) { OUTB[(dh * 16 + i) * 512] = g0 * ot[dh][i]; ot[dh][i] = 0.f; }
    if (tb < 16) { const unsigned long long mask = (1ull << (tb + 1)) - 1ull;
        if (lane < 8) { MSK[2 * (8 * wave + lane)] = (unsigned)mask; MSK[2 * (8 * wave + lane) + 1] = (unsigned)(mask >> 32); } }
    else {
        unsigned vb[8], T[8];
#pragma unroll
        for (int tk = 0; tk < 8; ++tk) { const int trow = 8 * wave + tk; vb[tk] = __float_as_uint(OWN[trow * 64 + lane] + SPL[trow * 65 + lane]); T[tk] = 0u; }
        const unsigned long long cm = __ballot((lane >= 1) && (lane <= tb - 2));
#pragma unroll 1
        for (int bit = 30; bit >= 0; --bit) {
#pragma unroll
            for (int tk = 0; tk < 8; ++tk) { const unsigned trial = T[tk] | (1u << bit);
                if (__builtin_popcountll(__ballot(vb[tk] >= trial) & cm) >= 13) T[tk] = trial; } }
#pragma unroll
        for (int tk = 0; tk < 8; ++tk) { const int trow = 8 * wave + tk;
            const unsigned long long gt = __ballot(vb[tk] > T[tk]) & cm; unsigned long long eq = __ballot(vb[tk] == T[tk]) & cm, pick = 0ull;
            for (int need = 13 - __builtin_popcountll(gt); need > 0; --need) { const unsigned long long low = eq & (0ull - eq); pick |= low; eq ^= low; }
            const unsigned long long mask = gt | pick | 1ull | (1ull << tb) | (1ull << (tb - 1));
            if (lane == 0) { MSK[2 * trow] = (unsigned)mask; MSK[2 * trow + 1] = (unsigned)(mask >> 32); } }
    }
    __syncthreads();
    unsigned long long mymask, wunion, bunion;
    { const unsigned lo = MSK[2 * (8 * wave + tokl)], hi = MSK[2 * (8 * wave + tokl) + 1]; mymask = ((unsigned long long)hi << 32) | lo;
      unsigned wl = lo, wh = hi;
      wl |= __shfl_xor(wl, 4); wh |= __shfl_xor(wh, 4); wl |= __shfl_xor(wl, 8); wh |= __shfl_xor(wh, 8); wl |= __shfl_xor(wl, 16); wh |= __shfl_xor(wh, 16);
      wunion = ((unsigned long long)(unsigned)__builtin_amdgcn_readfirstlane(wh) << 32) | (unsigned)__builtin_amdgcn_readfirstlane(wl);
      unsigned bl = MSK[2 * lane], bh = MSK[2 * lane + 1];
#pragma unroll
      for (int o = 1; o < 64; o <<= 1) { bl |= __shfl_xor(bl, o); bh |= __shfl_xor(bh, o); }
      bunion = ((unsigned long long)(unsigned)__builtin_amdgcn_readfirstlane(bh) << 32) | (unsigned)__builtin_amdgcn_readfirstlane(bl);
      bunion &= (tb == 63) ? ~0ull : ((1ull << (tb + 1)) - 1ull); }
    const bf16_t* ksb = proj + (size_t)(b * T_) * DIN + C_KV + 2 * 256 + g * 64 + lch * 8;
#define NS_ROW(j) ((size_t)(64 * (j) + lkey) * DIN)
    {
        m = -1e30f; l = 0.f;
        unsigned long long lcur = bunion, ccur = bunion;
#define NS_SEL_LOAD(KR, VR) { const int jj = lcur ? 63 - __builtin_clzll(lcur) : 0; lcur &= ~(1ull << jj); KR = *(const u32x4*)(ksb + NS_ROW(jj)); VR = *(const u32x4*)(vst + 64 * jj); }
#define NS_SEL_BODY(BUF) { const int j = 63 - __builtin_clzll(ccur); ccur &= ~(1ull << j); unsigned char* buf = (BUF); \
            if ((wunion >> j) & 1ull) { \
                if (j == tb) { ns_qk(buf, qf, qx, kx, c, hf, st, 0.f); ns_mask<1, true, false>(st, (float)(t - 64 * j - 4 * hf)); \
                    ns_softmax<true>(st, slope2 * (float)(64 * j - t), true, m, l, ot, buf + 64 * NS_KP, c, hf); } \
                else { ns_qk(buf, qf, qx, kx, c, hf, st, ((mymask >> j) & 1ull) ? slope2 * (float)(64 * j - t) - m : -INFINITY); \
                    ns_softmax_rel(st, m, l, ot, buf + 64 * NS_KP, c, hf); } } }
        NS_PIPE(__builtin_popcountll(bunion), NS_SEL_LOAD, NS_SEL_BODY);
        l += __shfl_xor(l, 32);
        const float f = g1 / l;
#pragma unroll
        for (int dh = 0; dh < 2; ++dh)
#pragma unroll
            for (int i = 0; i < 16; ++i) { OUTB[(dh * 16 + i) * 512] += f * ot[dh][i]; ot[dh][i] = 0.f; }
    }
    {
        m = -1e30f; l = 0.f;
        const bf16_t* kwb = ksb + 2 * 256;
        const int j0 = max(0, tb - 8);
        int lj = tb, cj = tb;
#define NS_WIN_LOAD(KR, VR) { const int lj_ = max(lj, j0); KR = *(const u32x4*)(kwb + NS_ROW(lj_)); VR = *(const u32x4*)(vwt + 64 * lj_); --lj; }
#define NS_WIN_BODY(BUF) { const int j = cj--; unsigned char* buf = (BUF); \
            if (j == tb) { ns_qk(buf, qf, qx, kx, c, hf, st, 0.f); ns_mask<1, true, false>(st, (float)(t - 64 * j - 4 * hf)); \
                ns_softmax<true>(st, slope2 * (float)(64 * j - t), true, m, l, ot, buf + 64 * NS_KP, c, hf); } \
            else { ns_qk(buf, qf, qx, kx, c, hf, st, slope2 * (float)(64 * j - t) - m); \
                if (j == j0) ns_mask<1, false, true>(st, (float)(t - 64 * j - 4 * hf)); \
                ns_softmax_rel(st, m, l, ot, buf + 64 * NS_KP, c, hf); } }
        NS_PIPE(tb - j0 + 1, NS_WIN_LOAD, NS_WIN_BODY);
        l += __shfl_xor(l, 32);
        const float f = g2 / l;
#pragma unroll
        for (int dh = 0; dh < 2; ++dh)
#pragma unroll
            for (int i = 0; i < 16; ++i) ot[dh][i] = OUTB[(dh * 16 + i) * 512] + f * ot[dh][i];
    }
#undef NS_ROW
#undef NS_CMP_ADDR
#undef NS_PIPE
#undef NS_CMP_LOAD
#undef NS_CMP1_BODY
#undef NS_CMP2_BODY
#undef NS_SEL_LOAD
#undef NS_SEL_BODY
#undef NS_WIN_LOAD
#undef NS_WIN_BODY
    bf16_t* orow = (bf16_t*)(p->ws + WS_MIX) + (size_t)(b * T_ + t) * D_ + hq * 64;
#pragma unroll
    for (int dh = 0; dh < 2; ++dh)
#pragma unroll
        for (int q4 = 0; q4 < 4; ++q4) { u32x2 w; w.x = pk2(ot[dh][4 * q4], ot[dh][4 * q4 + 1]); w.y = pk2(ot[dh][4 * q4 + 2], ot[dh][4 * q4 + 3]);
            *(u32x2*)(orow + dh * 32 + 8 * q4 + 4 * hf) = w; }
}
typedef float f32x4m __attribute__((ext_vector_type(4)));
__device__ __forceinline__ bf16x8 ldfrag(const unsigned char* base, int pitch, int row, int kbyte) { return *(const bf16x8*)(base + row * pitch + kbyte); }
#define MFMA16(a, b, c) __builtin_amdgcn_mfma_f32_16x16x32_bf16((a), (b), (c), 0, 0, 0)
constexpr int GQP = 272, GTP = 144;
constexpr int G_QT = 0, G_KT = 17408, G_KET = 34816, G_VT = 53248, G_ATT = 71680, G_ZS = 80896, G_SEG = 84992;

__device__ __forceinline__ void gla_prep_item2(KP p, int L, int item, unsigned char* smem) {
    const int tid = otid(), lane = tid & 63, wave = tid >> 6, b = item >> 8, n = (item >> 2) & 63, h = item & 3;
    const int fr = lane & 15, fq = lane >> 4;
    float* zs = (float*)(smem + G_ZS); float* segt = (float*)(smem + G_SEG);
    const bf16_t* proj = (const bf16_t*)(p->ws + WS_PROJ);
    const size_t row0 = (size_t)(b * T_ + n * 64);
    const int c = tid & 127, tq = tid >> 7;
    bf16_t qraw[16], kraw[16], vraw[16];
#pragma unroll
    for (int i = 0; i < 16; ++i) { const bf16_t* pr = proj + (row0 + tq * 16 + i) * DIN + h * 128 + c; qraw[i] = pr[C_GQ]; kraw[i] = pr[C_GK]; vraw[i] = pr[C_GV]; }
    for (int i = tid; i < 1024; i += NTHR) { const int t = i >> 4, r = i & 15; zs[i] = bf2f(proj[(row0 + t) * DIN + C_GZ + r]); }
    __syncthreads();
    float loc[16];
    { float w2c[16];
#pragma unroll
      for (int r = 0; r < 16; ++r) w2c[r] = p->in[13][((size_t)L * 16 + r) * 512 + h * 128 + c];
      const float bg = p->in[14][L * 512 + h * 128 + c]; float run = 0.f;
#pragma unroll
      for (int i = 0; i < 16; ++i) { const int t = tq * 16 + i; float x = bg;
#pragma unroll
          for (int r = 0; r < 16; ++r) x += zs[t * 16 + r] * w2c[r];
          const float ey = fexp(-fabsf(x)); const float l1p = (ey > 1e-3f) ? __builtin_amdgcn_logf(1.f + ey) * 0.6931471805599453f : ey - 0.5f * ey * ey;
          const float ls = fminf(x, 0.f) - l1p;
          run += ls * (1.f / 16.f); loc[i] = run; }
      segt[tq * 128 + c] = run; }
    __syncthreads();
    {
        float off = 0.f, bl = 0.f;
#pragma unroll
        for (int s = 0; s < 4; ++s) { const float v = segt[s * 128 + c]; bl += v; if (s < tq) off += v; }
        bf16_t* gqt = (bf16_t*)(p->ws + WS_GQT);
#pragma unroll
        for (int i = 0; i < 16; i += 2) { const int t0 = tq * 16 + i; float ke[2]; bf16_t vv[2];
#pragma unroll
            for (int e = 0; e < 2; ++e) { const int t = t0 + e; const float bc = loc[i + e] + off;
                const float kx = bf2f(kraw[i + e]); const bf16_t qb = f2bf(bf2f(qraw[i + e]) * 0.08838834764831845f * fexp(bc));
                *(bf16_t*)(smem + G_QT + t * GQP + c * 2) = qb; *(bf16_t*)(smem + G_KT + t * GQP + c * 2) = f2bf(kx * fexp(-bc));
                gqt[(row0 + t) * 512 + h * 128 + c] = qb; ke[e] = kx * fexp(bl - bc); vv[e] = vraw[i + e]; }
            *(unsigned*)(smem + G_KET + c * GTP + t0 * 2) = pk2(ke[0], ke[1]);
            *(unsigned*)(smem + G_VT + c * GTP + t0 * 2) = (unsigned)vv[0] | ((unsigned)vv[1] << 16); }
        if (tq == 0) ((float*)(p->ws + WS_GDEC))[(size_t)((b * 64 + n) * 4 + h) * 128 + c] = fexp(bl);
    }
    __syncthreads();
    { const int tt = wave & 3;
#pragma unroll
      for (int si = 0; si < 2; ++si) { const int stile = 2 * (wave >> 2) + si; f32x4m acc = {0.f, 0.f, 0.f, 0.f};
          if (stile <= tt) {
#pragma unroll
              for (int ks = 0; ks < 4; ++ks) acc = MFMA16(ldfrag(smem + G_QT, GQP, tt * 16 + fr, (32 * ks + 8 * fq) * 2), ldfrag(smem + G_KT, GQP, stile * 16 + fr, (32 * ks + 8 * fq) * 2), acc); }
#pragma unroll
          for (int r = 0; r < 4; ++r) { const int t = tt * 16 + fq * 4 + r, s = stile * 16 + fr;
              *(bf16_t*)(smem + G_ATT + t * GTP + s * 2) = (s <= t) ? f2bf(acc[r]) : (bf16_t)0; } } }
    __syncthreads();
    { const int tt = wave & 3; float* goi = (float*)(p->ws + WS_GOI);
#pragma unroll
      for (int vi = 0; vi < 4; ++vi) { const int vt = 4 * (wave >> 2) + vi; f32x4m acc = {0.f, 0.f, 0.f, 0.f};
#pragma unroll
          for (int ks = 0; ks < 2; ++ks) acc = MFMA16(ldfrag(smem + G_ATT, GTP, tt * 16 + fr, (32 * ks + 8 * fq) * 2), ldfrag(smem + G_VT, GTP, vt * 16 + fr, (32 * ks + 8 * fq) * 2), acc);
#pragma unroll
          for (int r = 0; r < 4; ++r) goi[(row0 + tt * 16 + fq * 4 + r) * 512 + h * 128 + vt * 16 + fr] = acc[r]; } }
    { float* gupd = (float*)(p->ws + WS_GUPD) + (size_t)((b * 64 + n) * 4 + h) * 16384;
      const bf16x8 a0 = ldfrag(smem + G_VT, GTP, wave * 16 + fr, (8 * fq) * 2), a1 = ldfrag(smem + G_VT, GTP, wave * 16 + fr, (32 + 8 * fq) * 2);
#pragma unroll
      for (int kt = 0; kt < 8; ++kt) { f32x4m acc = {0.f, 0.f, 0.f, 0.f};
          acc = MFMA16(a0, ldfrag(smem + G_KET, GTP, kt * 16 + fr, (8 * fq) * 2), acc);
          acc = MFMA16(a1, ldfrag(smem + G_KET, GTP, kt * 16 + fr, (32 + 8 * fq) * 2), acc);
#pragma unroll
          for (int r = 0; r < 4; ++r) gupd[(wave * 16 + fq * 4 + r) * 128 + kt * 16 + fr] = acc[r]; } }
    __syncthreads();
}

constexpr int GO_ST = 0, GO_QS = 34816, GO_SS = 52224;
__device__ __forceinline__ void gla_out_item2(KP p, int L, int item, unsigned char* smem) {
    const int tid = otid(), lane = tid & 63, wave = tid >> 6, b = item >> 8, n = (item >> 2) & 63, h = item & 3;
    const int fr = lane & 15, fq = lane >> 4;
    const float* gupd = (const float*)(p->ws + WS_GUPD) + (size_t)((b * 64 + n) * 4 + h) * 16384;
    const bf16_t* gqt = (const bf16_t*)(p->ws + WS_GQT); const float* goi = (const float*)(p->ws + WS_GOI);
    const bf16_t* proj = (const bf16_t*)(p->ws + WS_PROJ); bf16_t* mix = (bf16_t*)(p->ws + WS_MIX);
    const size_t row0 = (size_t)(b * T_ + n * 64);
#pragma unroll
    for (int i = 0; i < 8; ++i) { const int e = tid + 512 * i, v = e >> 5, k4 = (e & 31) * 4; const f32x4 s = *(const f32x4*)(gupd + v * 128 + k4);
        u32x2 o; o.x = pk2(s[0], s[1]); o.y = pk2(s[2], s[3]); *(u32x2*)(smem + GO_ST + v * GQP + k4 * 2) = o; }
#pragma unroll
    for (int i = 0; i < 2; ++i) { const int e = tid + 512 * i, t = e >> 4, k8 = (e & 15) * 8;
        *(u32x4*)(smem + GO_QS + t * GQP + k8 * 2) = *(const u32x4*)(gqt + (row0 + t) * 512 + h * 128 + k8); }
    const int tt = wave & 3, vh = wave >> 2;
    float goiv[4][4]; bf16_t rgv[4][4]; float gnv[4];
#pragma unroll
    for (int vi = 0; vi < 4; ++vi) { const int v = (4 * vh + vi) * 16 + fr; gnv[vi] = p->in[15][L * 512 + h * 128 + v];
#pragma unroll
        for (int r = 0; r < 4; ++r) { const size_t rw = row0 + tt * 16 + fq * 4 + r; goiv[vi][r] = goi[rw * 512 + h * 128 + v]; rgv[vi][r] = proj[rw * DIN + C_GR + h * 128 + v]; } }
    __syncthreads();
    f32x4m acc[4]; float ssq[4] = {0.f, 0.f, 0.f, 0.f};
#pragma unroll
    for (int vi = 0; vi < 4; ++vi) { const int vt = 4 * vh + vi; acc[vi] = (f32x4m){0.f, 0.f, 0.f, 0.f};
#pragma unroll
        for (int ks = 0; ks < 4; ++ks) acc[vi] = MFMA16(ldfrag(smem + GO_QS, GQP, tt * 16 + fr, (32 * ks + 8 * fq) * 2), ldfrag(smem + GO_ST, GQP, vt * 16 + fr, (32 * ks + 8 * fq) * 2), acc[vi]);
#pragma unroll
        for (int r = 0; r < 4; ++r) { acc[vi][r] += goiv[vi][r]; ssq[r] += acc[vi][r] * acc[vi][r]; } }
    float* SS = (float*)(smem + GO_SS);
#pragma unroll
    for (int r = 0; r < 4; ++r) { float s = ssq[r]; s += __shfl_xor(s, 1); s += __shfl_xor(s, 2); s += __shfl_xor(s, 4); s += __shfl_xor(s, 8);
        if (fr == 0) SS[vh * 64 + tt * 16 + fq * 4 + r] = s; }
    __syncthreads();
#pragma unroll
    for (int r = 0; r < 4; ++r) { const int t = tt * 16 + fq * 4 + r; const float rs = rsqrtf((SS[t] + SS[64 + t]) * (1.f / 128.f) + EPS);
#pragma unroll
        for (int vi = 0; vi < 4; ++vi) { const int v = (4 * vh + vi) * 16 + fr; const float rg = bf2f(rgv[vi][r]);
            mix[(row0 + t) * D_ + 1536 + h * 128 + v] = f2bf(acc[vi][r] * rs * gnv[vi] * (rg * sigm(rg))); } }
    __syncthreads();
}

constexpr int LXP = 1040, L_XC = 0, L_A = 66560, L_U = 66560 + 32768;
__device__ __forceinline__ void lru_prep_item2(KP p, int L, int item, unsigned char* smem) {
    const int tid = otid(), lane = tid & 63, wave = tid >> 6, c = tid, b = item >> 6, n = item & 63, fr = lane & 15, fq = lane >> 4;
    const bf16_t* proj = (const bf16_t*)(p->ws + WS_PROJ);
    const int t0 = n * 64;
    { float cw[4];
#pragma unroll
      for (int k = 0; k < 4; ++k) cw[k] = p->in[6][(L * 4 + k) * 512 + c];
      const float cb = p->in[7][L * 512 + c];
      float x0 = (t0 >= 3) ? bf2f(proj[(size_t)(b * T_ + t0 - 3) * DIN + C_LX + c]) : 0.f;
      float x1 = (t0 >= 2) ? bf2f(proj[(size_t)(b * T_ + t0 - 2) * DIN + C_LX + c]) : 0.f;
      float x2 = (t0 >= 1) ? bf2f(proj[(size_t)(b * T_ + t0 - 1) * DIN + C_LX + c]) : 0.f;
#pragma unroll 32
      for (int tt = 0; tt < 64; ++tt) { const float x3 = bf2f(proj[(size_t)(b * T_ + t0 + tt) * DIN + C_LX + c]);
          const float xc = cb + cw[0] * x0 + cw[1] * x1 + cw[2] * x2 + cw[3] * x3; x0 = x1; x1 = x2; x2 = x3;
          *(bf16_t*)(smem + L_XC + tt * LXP + c * 2) = f2bf(xc); } }
    const bf16_t* lwt = (const bf16_t*)(p->ws + WS_LWT);
    bf16x8 bw[2][4][2];
#pragma unroll
    for (int gt = 0; gt < 2; ++gt)
#pragma unroll
        for (int dt = 0; dt < 4; ++dt)
#pragma unroll
            for (int ks = 0; ks < 2; ++ks) bw[gt][dt][ks] = *(const bf16x8*)(lwt + ((size_t)(gt * 8 + wave) * 64 + dt * 16 + fr) * 64 + 32 * ks + 8 * fq);
    float bav[4], biv[4], spv[4];
#pragma unroll
    for (int dt = 0; dt < 4; ++dt) { const int cc = wave * 64 + dt * 16 + fr; bav[dt] = p->in[9][L * 512 + cc]; biv[dt] = p->in[11][L * 512 + cc]; spv[dt] = log1pf(expf(-p->in[12][L * 512 + cc])); }
    float* hl = (float*)(p->ws + WS_LH); float* pp = (float*)(p->ws + WS_LP);
    float* LA = (float*)(smem + L_A); float* LU = (float*)(smem + L_U);
    float hst = 0.f, Pst = 1.f;
    __syncthreads();
    for (int ts = 0; ts < 4; ++ts) {
        const bf16x8 a0 = ldfrag(smem + L_XC, LXP, ts * 16 + fr, (wave * 64 + 8 * fq) * 2), a1 = ldfrag(smem + L_XC, LXP, ts * 16 + fr, (wave * 64 + 32 + 8 * fq) * 2);
#pragma unroll
        for (int dt = 0; dt < 4; ++dt) { f32x4m ra = {0.f, 0.f, 0.f, 0.f}, ri = {0.f, 0.f, 0.f, 0.f};
            ra = MFMA16(a0, bw[0][dt][0], ra); ra = MFMA16(a1, bw[0][dt][1], ra); ri = MFMA16(a0, bw[1][dt][0], ri); ri = MFMA16(a1, bw[1][dt][1], ri);
#pragma unroll
            for (int r = 0; r < 4; ++r) { const int tl = fq * 4 + r, cc = wave * 64 + dt * 16 + fr;
                const float xc = bf2f(*(const bf16_t*)(smem + L_XC + (ts * 16 + tl) * LXP + cc * 2));
                const float rr = sigm(ra[r] + bav[dt]), ig = sigm(ri[r] + biv[dt]); const float log_a = -8.f * rr * spv[dt];
                const float av = fexp(log_a); LA[tl * 512 + cc] = av; LU[tl * 512 + cc] = __builtin_amdgcn_sqrtf(fmaxf(1.f - av * av, 0.f)) * (ig * xc); } }
        __syncthreads();
#pragma unroll
        for (int tl = 0; tl < 16; ++tl) { const float a = LA[tl * 512 + c]; hst = a * hst + LU[tl * 512 + c]; Pst *= a;
            const size_t o = (size_t)(b * T_ + t0 + ts * 16 + tl) * 512 + c; hl[o] = hst; pp[o] = Pst; }
        __syncthreads();
    }
}

__device__ __forceinline__ void compress_item2(KP p, int item, unsigned char* smem) {
    const int tid = otid(), lane = tid & 63, wave = tid >> 6, fr = lane & 15, fq = lane >> 4;
    const int kv = item >> 7, b = (item >> 6) & 1, g = (item >> 4) & 3, nt = item & 15;
    const bf16_t* proj = (const bf16_t*)(p->ws + WS_PROJ);
    const bf16_t* wct = (const bf16_t*)(p->ws + WS_WCT) + (size_t)kv * 64 * 2048;
    const int nrow = min(nt * 16 + fr, NCMP - 1);
    const bf16_t* arow = proj + (size_t)(b * T_ + 16 * nrow) * DIN + C_KV + kv * 256 + g * 64;
    f32x4m acc[4];
#pragma unroll
    for (int ot = 0; ot < 4; ++ot) acc[ot] = (f32x4m){0.f, 0.f, 0.f, 0.f};
#pragma unroll
    for (int kk = 0; kk < 8; ++kk) { const int ks = wave * 8 + kk, l = ks >> 1, d0 = 32 * (ks & 1) + 8 * fq;
        const bf16x8 a = *(const bf16x8*)(arow + (size_t)l * DIN + d0);
#pragma unroll
        for (int ot = 0; ot < 4; ++ot) acc[ot] = MFMA16(a, *(const bf16x8*)(wct + (size_t)(ot * 16 + fr) * 2048 + 32 * ks + 8 * fq), acc[ot]); }
    float* part = (float*)smem;
#pragma unroll
    for (int ot = 0; ot < 4; ++ot)
#pragma unroll
        for (int r = 0; r < 4; ++r) part[wave * 1024 + (fq * 4 + r) * 64 + ot * 16 + fr] = acc[ot][r];
    __syncthreads();
    { const int row = tid >> 5, col = (tid & 31) * 2, nn = nt * 16 + row; float s0 = 0.f, s1 = 0.f;
#pragma unroll
      for (int w = 0; w < 8; ++w) { s0 += part[w * 1024 + row * 64 + col]; s1 += part[w * 1024 + row * 64 + col + 1]; }
      const float* peb = (const float*)(p->ws + WS_PEB) + kv * 64;
      if (kv == 0) { if (nn < NCMP) *(unsigned*)((bf16_t*)(p->ws + WS_KC) + ((size_t)(b * NCMP + nn) * 4 + g) * 64 + col) = pk2(s0 + peb[col], s1 + peb[col + 1]); }
      else { bf16_t* vt = (bf16_t*)(p->ws + WS_VCT) + ((size_t)((b * 4 + g) * 64 + col)) * 256 + nn;
          vt[0] = (nn < NCMP) ? f2bf(s0 + peb[col]) : (bf16_t)0; vt[256] = (nn < NCMP) ? f2bf(s1 + peb[col + 1]) : (bf16_t)0; } }
    __syncthreads();
}
__device__ __forceinline__ void vt_item(KP p, int item, unsigned char* scr, int lane) {
    const int br = item >> 9, b = (item >> 8) & 1, g = (item >> 6) & 3, tt = item & 63;
    const bf16_t* src = (const bf16_t*)(p->ws + WS_PROJ) + (size_t)(b * T_ + tt * 64) * DIN + C_KV + (br ? 5 : 3) * 256 + g * 64;
#pragma unroll
    for (int i = 0; i < 8; ++i) { const int q = lane + 64 * i, row = q >> 3, ch = q & 7; *(u32x4*)(scr + row * 144 + ch * 16) = *(const u32x4*)(src + (size_t)row * DIN + ch * 8); }
    asm volatile("s_waitcnt lgkmcnt(0)" ::: "memory");
    bf16_t* dst = (bf16_t*)(p->ws + (br ? WS_VWT : WS_VST)) + ((size_t)((b * 4 + g) * 64 + lane)) * T_ + tt * 64;
#pragma unroll
    for (int k8 = 0; k8 < 8; ++k8) { unsigned short e[8];
#pragma unroll
        for (int j = 0; j < 8; ++j) e[j] = *(const unsigned short*)(scr + (k8 * 8 + j) * 144 + lane * 2);
        u32x4 w; w.x = e[0] | ((unsigned)e[1] << 16); w.y = e[2] | ((unsigned)e[3] << 16); w.z = e[4] | ((unsigned)e[5] << 16); w.w = e[6] | ((unsigned)e[7] << 16);
        *(u32x4*)(dst + k8 * 8) = w; }
    asm volatile("s_waitcnt lgkmcnt(0)" ::: "memory");
}
__device__ __forceinline__ void convert_small(KP p, int L, unsigned char* smem) {
    const int tid = otid(), lane = tid & 63, wave = tid >> 6;
    float* scr = (float*)smem + wave * TSCR;
    const int gw = blockIdx.x * 8 + wave, NGW = gridDim.x * 8;
    for (int it = gw; it < 64; it += NGW) { const int kv = it >> 5;
        transpose_item(p->in[4] + ((size_t)L * 2 + kv) * 2048 * 64, 2048, 64, (bf16_t*)(p->ws + WS_WCT) + (size_t)kv * 64 * 2048, scr, it & 31, lane); }
    const int gt = blockIdx.x * NTHR + tid, GT = gridDim.x * NTHR;
    for (int e = gt; e < 2 * 8 * 4096; e += GT) { const int gate = e >> 15, r = e & 32767, blk = r >> 12, d = (r >> 6) & 63, cp = r & 63;
        const float* src = (gate ? p->in[10] : p->in[8]) + (size_t)L * 8 * 4096 + blk * 4096 + cp * 64 + d;
        ((bf16_t*)(p->ws + WS_LWT))[e] = f2bf(*src); }
    for (int it = gw; it < 128; it += NGW) { const int kv = it >> 6, o = it & 63;
        const float* W = p->in[4] + ((size_t)L * 2 + kv) * 2048 * 64; const float* pe = p->in[5] + ((size_t)L * 2 + kv) * 2048;
        float s = 0.f;
#pragma unroll 8
        for (int k = lane; k < 2048; k += 64) s += pe[k] * W[(size_t)k * 64 + o];
        s = wave_sum(s);
        if (lane == 0) ((float*)(p->ws + WS_PEB))[it] = s; }
}
#define KPP kparams()
#define WSP (kparams()->ws)
#define U ((bf16_t*)(WSP + WS_U))
#define H ((float*)(WSP + WS_H))
#define E ((bf16_t*)(WSP + WS_E))
#define PB ((bf16_t*)(WSP + WS_PB))
#define PROJ ((bf16_t*)(WSP + WS_PROJ))
#define MIX ((bf16_t*)(WSP + WS_MIX))
#define ACT ((bf16_t*)(WSP + WS_ACT))
#define Y ((bf16_t*)(WSP + WS_Y))
template <int L> __device__ __forceinline__ void layer_body(unsigned char* smem, const XcdBarrier& xb, const int G, const int bx) {
        convert_weights(KPP, L, 31, osm(smem));
        convert_small(KPP, L, osm(smem));
        __syncthreads();
        row_phase(L == 0 ? KPP->in[0] : H, nullptr, nullptr, nullptr, KPP->in[2] + L * D_, U);
        xcd_barrier(xb);
        run_gemm(osm(smem), U, (const bf16_t*)(WSP + WS_WIN), M_, DINP, D_, EpiBf16P<0>{PROJ, DIN, DIN});
        xcd_barrier(xb);
        { const int tid = otid(), wave = tid >> 6, lane = tid & 63; unsigned char* sm = osm(smem); for (int it = bx * 8 + wave; it < 1024; it += G * 8) vt_item(KPP, it, sm + wave * 9216, lane); __syncthreads(); }
        for (int it = bx; it < 128; it += G) lru_prep_item2(KPP, L, it, osm(smem));
        if (G == 256) { if (bx < 128) gla_prep_item2(KPP, L, bx, osm(smem)); else for (int q = 0; q < 3; ++q) gla_prep_item2(KPP, L, 128 + (bx - 128) * 3 + q, osm(smem)); }
        else for (int it = bx; it < 512; it += G) gla_prep_item2(KPP, L, it, osm(smem));
        for (int it = bx; it < 256; it += G) compress_item2(KPP, it, osm(smem));
        xcd_barrier(xb);
        gla_scan(KPP);
        for (int it = bx; it < 512; it += G) nsa_item(KPP, it, osm(smem));
        for (int it = bx; it < 256; it += G) lru_out_item(KPP, it);
        xcd_barrier(xb);
        for (int it = bx; it < 512; it += G) gla_out_item2(KPP, L, it, osm(smem));
        xcd_barrier(xb);
        run_gemm(osm(smem), MIX, (const bf16_t*)(WSP + WS_WOUT), M_, D_, D_, EpiBf16P<0>{Y, D_, D_});
        run_gemm(osm(smem), PB + (size_t)L * M_ * PLE, (const bf16_t*)(WSP + WS_WP), M_, D_, PLE, EpiBf16P<0>{E, D_, D_});
        xcd_barrier(xb);
        row_phase(L == 0 ? KPP->in[0] : H, Y, KPP->in[17] + L * D_, H, KPP->in[18] + L * D_, U);
        xcd_barrier(xb);
        run_gemm(osm(smem), U, (const bf16_t*)(WSP + WS_WUP), M_, DFF, D_, EpiBf16P<1>{ACT, DFF, DFF});
        xcd_barrier(xb);
        run_gemm(osm(smem), ACT, (const bf16_t*)(WSP + WS_WDN), M_, D_, DFF, EpiBf16P<0>{Y, D_, D_});
        xcd_barrier(xb);
        row_phase(H, Y, KPP->in[21] + L * D_, H, nullptr, U);
        xcd_barrier(xb);
        run_gemm(osm(smem), U, (const bf16_t*)(WSP + WS_WG), M_, D_, D_, EpiPle{L == 1 ? KPP->out : H, H, E, D_});
        xcd_barrier(xb);
    }
__global__ void __launch_bounds__(512, 2) mega(Params p_unused) {
    extern __shared__ __attribute__((aligned(16))) unsigned char smem[];
    cg::grid_group grid = cg::this_grid();
    const int G = gridDim.x, bx = blockIdx.x;
    { const int tid = otid(); unsigned* bar0 = (unsigned*)(kparams()->ws + WS_BAR);
      if (bx == 0) for (int i = tid; i < XCD_BAR_WORDS; i += NTHR) bar0[i] = 0u;
      if (tid < 4) ((unsigned*)(smem + LDS_BYTES - 16))[tid] = 0u;
      __threadfence(); }
    grid.sync();
    const XcdBarrier xb = xcd_barrier_post((unsigned*)(kparams()->ws + WS_BAR), (volatile XB_LAS unsigned*)(smem + LDS_BYTES - 16));
    { const int tid = otid(); const f32x4* src = (const f32x4*)KPP->in[1]; u32x2* dst = (u32x2*)PB; const int n4 = 2 * M_ * PLE / 4;
      for (int i = bx * NTHR + tid; i < n4; i += G * NTHR) { const f32x4 v = src[i]; u32x2 o; o.x = pk2(v[0], v[1]); o.y = pk2(v[2], v[3]); dst[i] = o; } }
    layer_body<0>(smem, xb, G, bx);
    layer_body<1>(smem, xb, G, bx);
}
#undef KPP
#undef WSP
#undef U
#undef H
#undef E
#undef PB
#undef PROJ
#undef MIX
#undef ACT
#undef Y
}

extern "C" void kernel_launch(void* const* d_in, const int* in_sizes, int n_in, void* d_out, int out_size, void* d_ws, size_t ws_size, hipStream_t stream) {
    static int grid = 0;
    if (grid == 0) {
        if (n_in != 24 || ws_size < mk::WS_END) { fprintf(stderr, "kernel_launch: unexpected n_in %d / ws %zu\n", n_in, ws_size); grid = -1; return; }
        int dev = 0, cus = 0, per = 0;
        hipGetDevice(&dev); hipDeviceGetAttribute(&cus, hipDeviceAttributeMultiprocessorCount, dev);
        if (hipFuncSetAttribute((const void*)mk::mega, hipFuncAttributeMaxDynamicSharedMemorySize, mk::LDS_BYTES) != hipSuccess) fprintf(stderr, "kernel_launch: hipFuncSetAttribute failed\n");
        if (hipOccupancyMaxActiveBlocksPerMultiprocessor(&per, (const void*)mk::mega, mk::NTHR, mk::LDS_BYTES) != hipSuccess || per < 1) { fprintf(stderr, "kernel_launch: occupancy query says %d\n", per); per = 1; }
        (void)hipGetLastError();
        grid = cus;
    }
    if (grid < 0) return;
    mk::Params p{};
    for (int i = 0; i < 24; ++i) p.in[i] = (const float*)d_in[i];
    p.out = (float*)d_out; p.ws = (unsigned char*)d_ws;
    void* args[] = {&p};
    hipError_t e = hipLaunchCooperativeKernel((const void*)mk::mega, dim3(grid), dim3(mk::NTHR), args, mk::LDS_BYTES, stream);
    if (e != hipSuccess) fprintf(stderr, "kernel_launch: cooperative launch failed: %s (grid %d)\n", hipGetErrorString(e), grid);
}
```
